# Optimizing an MI355X kernel written in HIP

```python
import numpy as np
import jax
import jax.numpy as jnp
from jax import lax

D_MODEL = 1024
BATCH = 16
SEQ = 2048
DEPTH = 2

GRID_W = 64
CTX_LEN = 256

NA_HEADS = 8
NA_HEAD_DIM = 64
NA_WIDTH = NA_HEADS * NA_HEAD_DIM
NA_KH = 8
NA_KW = 16
NA_QB = 16
NA_BAND = 32
NA_NCB = GRID_W // NA_QB
LRU_WIDTH = 512
LRU_BLOCKS = 8
LRU_BLOCK = LRU_WIDTH // LRU_BLOCKS
LRU_CONV = 4
LRU_CONV_LEFT = 2
LRU_C = 8.0
SC_WIDTH = D_MODEL
SC_K = 3
D_FF = 2816
FFN_RES = 0.5
N_SUB = 3
N_MOD = 3 * N_SUB
ALPHA = (2.0 * DEPTH) ** 0.25
BETA = (8.0 * DEPTH) ** -0.25
LN_EPS = 1e-5
NEG_INF = -1e30

N_EVEN = (DEPTH + 1) // 2
N_ODD = DEPTH // 2
MIX0_IN = 3 * NA_WIDTH + 2 * LRU_WIDTH
MIX0_OUT = NA_WIDTH + LRU_WIDTH

kernel_name = 'hybrid_na_rglru_shortconv_dit'


def layer_norm(h, g, b):
    hf = h.astype(jnp.float32)
    mu = jnp.mean(hf, axis=-1, keepdims=True)
    var = jnp.mean(jnp.square(hf - mu), axis=-1, keepdims=True)
    return ((hf - mu) * lax.rsqrt(var + LN_EPS)).astype(h.dtype) * g + b


def modulate(h, m, k):
    return h * (1 + m[..., 3 * k + 1, :]) + m[..., 3 * k, :]


def post_norm_residual(h, y, m, k, g, b, res_w):
    return layer_norm(ALPHA * h + res_w * m[..., 3 * k + 2, :] * y, g, b)


def swiglu(h, w1, w3, w2):
    return (jax.nn.silu(h @ w1) * (h @ w3)) @ w2


def depthwise_conv(h, w, left):
    k, ch = w.shape
    return lax.conv_general_dilated(
        h, w[:, None, :].astype(h.dtype), (1,), [(left, k - 1 - left)],
        dimension_numbers=('NWC', 'WIO', 'NWC'), feature_group_count=ch)


def _na_column_tables():
    j = np.arange(NA_NCB)[:, None, None]
    u = np.arange(NA_QB)[None, :, None]
    v = np.arange(NA_BAND)[None, None, :]
    band = np.clip(NA_QB * np.arange(NA_NCB) - NA_KW // 2, 0, GRID_W - NA_BAND)
    q_col = NA_QB * j + u
    k_col = band[:, None, None] + v
    start = np.clip(q_col - NA_KW // 2, 0, GRID_W - NA_KW)
    mask = (k_col >= start) & (k_col < start + NA_KW)
    col_idx = np.clip(k_col - q_col + NA_KW - 1, 0, 2 * NA_KW - 2)
    return [int(s) for s in band], mask, col_idx


def neighbourhood_attention(q, k, v, k_ctx, v_ctx, rpb):
    bsz, n, nh, hd = q.shape
    rows = n // GRID_W
    kh = min(NA_KH, rows)
    nk = kh * NA_BAND
    bands, col_mask, col_idx = _na_column_tables()
    mask = np.broadcast_to(col_mask[:, :, None, :], (NA_NCB, NA_QB, kh, NA_BAND)).reshape(NA_NCB, NA_QB, nk)
    scale = hd ** -0.5
    qg = q.reshape(bsz, rows, NA_NCB, NA_QB, nh, hd)
    kg = k.reshape(bsz, rows, GRID_W, nh, hd)
    vg = v.reshape(bsz, rows, GRID_W, nh, hd)
    rpb_f = rpb.astype(jnp.float32)

    def gather_bands(t_rows):
        t = jnp.stack([t_rows[:, :, s:s + NA_BAND] for s in bands], axis=1)
        return t.reshape(bsz, NA_NCB, nk, nh, hd)

    def row_block(r):
        r0 = jnp.clip(r - kh // 2, 0, rows - kh)
        kb = gather_bands(lax.dynamic_slice_in_dim(kg, r0, kh, axis=1))
        vb = gather_bands(lax.dynamic_slice_in_dim(vg, r0, kh, axis=1))
        qr = lax.dynamic_index_in_dim(qg, r, axis=1, keepdims=False)
        s_loc = jnp.einsum('bjqhd,bjkhd->bhjqk', qr, kb, preferred_element_type=jnp.float32) * scale
        s_ctx = jnp.einsum('bjqhd,bchd->bhjqc', qr, k_ctx, preferred_element_type=jnp.float32) * scale
        row_off = r0 + jnp.arange(kh) - r + NA_KH - 1
        bias = rpb_f[:, row_off][:, :, col_idx]
        bias = bias.transpose(0, 2, 3, 1, 4).reshape(nh, NA_NCB, NA_QB, nk)
        s_loc = jnp.where(mask, s_loc + bias, NEG_INF)
        p = jax.nn.softmax(jnp.concatenate([s_loc, s_ctx], axis=-1), axis=-1).astype(v.dtype)
        return (jnp.einsum('bhjqk,bjkhd->bjqhd', p[..., :nk], vb)
                + jnp.einsum('bhjqc,bchd->bjqhd', p[..., nk:], v_ctx))

    out = lax.map(row_block, jnp.arange(rows))
    return jnp.moveaxis(out, 0, 1).reshape(bsz, n, nh * hd)


def context_attention(q, k, v):
    bsz, n, nh, hd = q.shape
    s = jnp.einsum('bqhd,bkhd->bhqk', q, k, preferred_element_type=jnp.float32) * hd ** -0.5
    p = jax.nn.softmax(s, axis=-1).astype(v.dtype)
    return jnp.einsum('bhqk,bkhd->bqhd', p, v).reshape(bsz, n, nh * hd)


def rglru_coeffs(xc, w_a, b_a, w_x, b_x, lam):
    bsz, n, rw = xc.shape
    xb = xc.reshape(bsz, n, LRU_BLOCKS, LRU_BLOCK)
    gate_r = jax.nn.sigmoid((jnp.einsum('bsnk,nkj->bsnj', xb, w_a).reshape(bsz, n, rw) + b_a).astype(jnp.float32))
    gate_i = jax.nn.sigmoid((jnp.einsum('bsnk,nkj->bsnj', xb, w_x).reshape(bsz, n, rw) + b_x).astype(jnp.float32))
    log_a = LRU_C * gate_r * jax.nn.log_sigmoid(lam.astype(jnp.float32))
    a = jnp.exp(log_a)
    b = jnp.sqrt(-jnp.expm1(2.0 * log_a)) * (gate_i * xc.astype(jnp.float32))
    return a, b


def linear_scan(a, b, h0):
    def combine(left, right):
        return left[0] * right[0], right[0] * left[1] + right[1]
    a_cum, h = lax.associative_scan(combine, (a, b), axis=1)
    return h + a_cum * h0[:, None, :]


def rglru_bidirectional(xc, w_a, b_a, w_x, b_x, lam, h0_fwd, h0_bwd):
    a_f, b_f = rglru_coeffs(xc, w_a[0], b_a[0], w_x[0], b_x[0], lam[0])
    a_b, b_b = rglru_coeffs(xc, w_a[1], b_a[1], w_x[1], b_x[1], lam[1])
    h_f = linear_scan(a_f, b_f, h0_fwd)
    h_b = linear_scan(a_b[:, ::-1], b_b[:, ::-1], h0_bwd)[:, ::-1]
    return (h_f + h_b).astype(xc.dtype), h_f[:, -1], h_b[:, 0]


def even_mixer(z, z_ctx, w_in, rpb, conv_w, conv_b, w_a, b_a, w_x, b_x, lam, w_out, with_ctx_out):
    cuts = [NA_WIDTH, 2 * NA_WIDTH, 3 * NA_WIDTH, 3 * NA_WIDTH + LRU_WIDTH]

    def project(t):
        bsz, n, _ = t.shape
        q, k, v, xr, gr = jnp.split(t @ w_in, cuts, axis=-1)
        hs = (bsz, n, NA_HEADS, NA_HEAD_DIM)
        xr = depthwise_conv(xr, conv_w, LRU_CONV_LEFT) + conv_b
        return q.reshape(hs), k.reshape(hs), v.reshape(hs), xr, gr

    qc, kc, vc, xc, gc = project(z_ctx)
    q, k, v, xl, gl = project(z)
    zeros = jnp.zeros((z.shape[0], LRU_WIDTH), jnp.float32)
    y_c, hf_ctx, hb_ctx = rglru_bidirectional(xc, w_a, b_a, w_x, b_x, lam, zeros, zeros)
    y_l, _, _ = rglru_bidirectional(xl, w_a, b_a, w_x, b_x, lam, hf_ctx, hb_ctx)
    na = neighbourhood_attention(q, k, v, kc, vc, rpb)
    out = jnp.concatenate([na, y_l * jax.nn.gelu(gl)], axis=-1) @ w_out
    out_ctx = None
    if with_ctx_out:
        ca = context_attention(qc, kc, vc)
        out_ctx = jnp.concatenate([ca, y_c * jax.nn.gelu(gc)], axis=-1) @ w_out
    return out, out_ctx


def short_conv_mixer(z, w_in, conv_w, w_out):
    gate_b, gate_c, xv = jnp.split(z @ w_in, 3, axis=-1)
    return (gate_b * depthwise_conv(gate_c * xv, conv_w, 1)) @ w_out


def setup_inputs(seed: int = 0) -> dict:
    key = jax.random.key(seed)
    ks = jax.random.split(key, 24)
    f32 = jnp.float32
    D = D_MODEL

    def nrm(k, shape, s):
        return jax.random.normal(k, shape, f32) * s

    u = jax.random.uniform(ks[19], (N_EVEN, 2, LRU_WIDTH), f32, 0.9, 0.999)
    s = u ** (1.0 / LRU_C)
    return {
        'x': nrm(ks[0], (BATCH, SEQ, D), 1.0),
        'c': nrm(ks[1], (BATCH, D), 1.0),
        'ctx': nrm(ks[2], (BATCH, CTX_LEN, D), 1.0),
        'c_ctx': nrm(ks[3], (D,), 1.0),
        'mod_w': nrm(ks[4], (DEPTH, D, N_MOD * D), 0.5 * D ** -0.5),
        'mod_b': nrm(ks[5], (DEPTH, N_MOD * D), 0.02),
        'ln_g': 1.0 + nrm(ks[6], (DEPTH, N_SUB, D), 0.02),
        'ln_b': nrm(ks[7], (DEPTH, N_SUB, D), 0.02),
        'ffn_w1': nrm(ks[8], (DEPTH, 2, D, D_FF), D ** -0.5),
        'ffn_w3': nrm(ks[9], (DEPTH, 2, D, D_FF), D ** -0.5),
        'ffn_w2': nrm(ks[10], (DEPTH, 2, D_FF, D), BETA * D_FF ** -0.5),
        'mix0_w_in': nrm(ks[11], (N_EVEN, D, MIX0_IN), D ** -0.5),
        'na_rpb': nrm(ks[12], (N_EVEN, NA_HEADS, 2 * NA_KH - 1, 2 * NA_KW - 1), 0.1),
        'lru_conv_w': nrm(ks[13], (N_EVEN, LRU_CONV, LRU_WIDTH), LRU_CONV ** -0.5),
        'lru_conv_b': nrm(ks[14], (N_EVEN, LRU_WIDTH), 0.02),
        'lru_w_a': nrm(ks[15], (N_EVEN, 2, LRU_BLOCKS, LRU_BLOCK, LRU_BLOCK), LRU_BLOCK ** -0.5),
        'lru_b_a': nrm(ks[16], (N_EVEN, 2, LRU_WIDTH), 0.02),
        'lru_w_x': nrm(ks[17], (N_EVEN, 2, LRU_BLOCKS, LRU_BLOCK, LRU_BLOCK), LRU_BLOCK ** -0.5),
        'lru_b_x': nrm(ks[18], (N_EVEN, 2, LRU_WIDTH), 0.02),
        'lru_lambda': jnp.log(s) - jnp.log1p(-s),
        'mix0_w_out': nrm(ks[20], (N_EVEN, MIX0_OUT, D), BETA * MIX0_OUT ** -0.5),
        'mix1_w_in': nrm(ks[21], (N_ODD, D, 3 * SC_WIDTH), D ** -0.5),
        'sconv_w': nrm(ks[22], (N_ODD, SC_K, SC_WIDTH), SC_K ** -0.5),
        'mix1_w_out': nrm(ks[23], (N_ODD, SC_WIDTH, D), BETA * SC_WIDTH ** -0.5),
    }


def reference(x, c, ctx, c_ctx, mod_w, mod_b, ln_g, ln_b, ffn_w1, ffn_w3, ffn_w2,
              mix0_w_in, na_rpb, lru_conv_w, lru_conv_b, lru_w_a, lru_b_a, lru_w_x, lru_b_x,
              lru_lambda, mix0_w_out, mix1_w_in, sconv_w, mix1_w_out):
    h = x
    hc = ctx
    cond = jax.nn.silu(c)
    cond_ctx = jax.nn.silu(c_ctx)
    for layer in range(DEPTH):
        even = layer % 2 == 0
        ctx_next = layer < DEPTH - 1
        ctx_here = ctx_next or even
        m = (cond @ mod_w[layer] + mod_b[layer]).reshape(-1, 1, N_MOD, D_MODEL)
        mc = (cond_ctx @ mod_w[layer] + mod_b[layer]).reshape(N_MOD, D_MODEL)

        w1, w3, w2 = ffn_w1[layer, 0], ffn_w3[layer, 0], ffn_w2[layer, 0]
        g, b = ln_g[layer, 0], ln_b[layer, 0]
        h = post_norm_residual(h, swiglu(modulate(h, m, 0), w1, w3, w2), m, 0, g, b, FFN_RES)
        if ctx_here:
            hc = post_norm_residual(hc, swiglu(modulate(hc, mc, 0), w1, w3, w2), mc, 0, g, b, FFN_RES)

        if even:
            e = layer // 2
            y, yc = even_mixer(modulate(h, m, 1), modulate(hc, mc, 1), mix0_w_in[e], na_rpb[e],
                               lru_conv_w[e], lru_conv_b[e], lru_w_a[e], lru_b_a[e], lru_w_x[e],
                               lru_b_x[e], lru_lambda[e], mix0_w_out[e], ctx_next)
        else:
            o = layer // 2
            y = short_conv_mixer(modulate(h, m, 1), mix1_w_in[o], sconv_w[o], mix1_w_out[o])
            yc = short_conv_mixer(modulate(hc, mc, 1), mix1_w_in[o], sconv_w[o], mix1_w_out[o]) if ctx_next else None
        g, b = ln_g[layer, 1], ln_b[layer, 1]
        h = post_norm_residual(h, y, m, 1, g, b, 1.0)

        w1, w3, w2 = ffn_w1[layer, 1], ffn_w3[layer, 1], ffn_w2[layer, 1]
        g2, b2 = ln_g[layer, 2], ln_b[layer, 2]
        if ctx_next:
            hc = post_norm_residual(hc, yc, mc, 1, g, b, 1.0)
            hc = post_norm_residual(hc, swiglu(modulate(hc, mc, 2), w1, w3, w2), mc, 2, g2, b2, FFN_RES)
        h = post_norm_residual(h, swiglu(modulate(h, m, 2), w1, w3, w2), m, 2, g2, b2, FFN_RES)
    return h
```

```cpp
#include <hip/hip_runtime.h>
#include <hip/hip_cooperative_groups.h>
#include <cstdio>
#include <cstdint>
namespace cg = cooperative_groups;
namespace pg8 {
#define PG8_LAS __attribute__((address_space(3)))
typedef unsigned short bf16_t;
typedef short bf16x8 __attribute__((ext_vector_type(8)));
typedef float f32x4 __attribute__((ext_vector_type(4)));
typedef unsigned u32x4 __attribute__((ext_vector_type(4)));
constexpr int BM = 256, BK = 64, HALF = 128, HTB = HALF * BK * 2  , STAGE_BYTES = 8 * HTB, NXCD = 8, WGM = 8;

__host__ __device__ __forceinline__ int lds_byte(int r, int c) { const int st = (r >> 4) * 2 + (c >> 5), rr = r & 15, cc = c & 31, ob = rr * 64 + cc * 2; return st * 1024 + (ob ^ (((ob >> 9) & 1) << 5)); }
__host__ __device__ __forceinline__ void stage_rc(int b, int& R, int& C) { const int st = b / 1024, sb = b % 1024, swz = sb ^ (((sb >> 9) & 1) << 5); R = (st >> 1) * 16 + swz / 64; C = (st & 1) * 32 + (swz % 64) / 2; }
__host__ __device__ __forceinline__ int perm32(int rho) { const int n = rho >> 4, i = rho & 15; return 8 * (i >> 2) + 4 * n + (i & 3); }

struct Unit { int pm, pn; };
struct Gemm { const bf16_t* A; const bf16_t* Bt; int M, N, K; };

struct StaticOrder {
    int nM, nN, nwg, G, c;
    __host__ __device__ void init(int M, int N, int G_, int c_) { nM = M / BM; nN = N / BM; nwg = nM * nN; G = G_; c = c_; }
    __host__ __device__ bool next(int i, Unit& u) const {
        const long L = (long)i * G + c; if (L >= nwg) return false;
        int wgid = (int)L; { const int q = nwg / NXCD, r = nwg % NXCD, xcd = wgid % NXCD, off = wgid / NXCD; wgid = (xcd < r ? xcd * (q + 1) : r * (q + 1) + (xcd - r) * q) + off; }
        const int nig = WGM * nN, gid = wgid / nig, fm = gid * WGM, gsz = (nM - fm) < WGM ? (nM - fm) : WGM;
        u.pm = fm + ((wgid % nig) % gsz); u.pn = (wgid % nig) / gsz; return true;
    }
    __device__ __forceinline__ void a_ready(const Unit&) const {}
    __device__ __forceinline__ void done(const Unit&) const {}
};

__device__ __forceinline__ unsigned cvt_pk_bf16(float lo, float hi) { unsigned r; asm volatile("v_cvt_pk_bf16_f32 %0, %1, %2" : "=v"(r) : "v"(lo), "v"(hi)); return r; }
typedef float f32x2 __attribute__((ext_vector_type(2)));
__device__ __forceinline__ f32x2 gelu_pk(f32x2 v) {
    const f32x2 av = __builtin_elementwise_abs(v), d = av * 0.2316418882f + 1.0f;
    f32x2 t; t.x = __builtin_amdgcn_rcpf(d.x); t.y = __builtin_amdgcn_rcpf(d.y);
    f32x2 q = t * 0.5307027145f + (-0.7265760135f); q = q * t + 0.7107068705f; q = q * t + (-0.142248368f); q = q * t + 0.127414796f; q = q * t;
    const f32x2 s = (v * v) * (-0.72134752044f);
    f32x2 e; e.x = __builtin_amdgcn_exp2f(s.x); e.y = __builtin_amdgcn_exp2f(s.y);
    const f32x2 m = v * (q * e), r = v - m;
    f32x2 o; o.x = v.x < 0.f ? m.x : r.x; o.y = v.y < 0.f ? m.y : r.y; return o;
}

template <int ACT  > struct EpiBf16 {
    static constexpr bool PERM = true, AFTER_DRAIN = false; static_assert(ACT == 0 || ACT == 1, "EpiBf16: ACT is 0 (none) or 1 (gelu_pk)");
    bf16_t* O; int ldc; const float* bias; int split_cols; size_t split_stride; float scale0;
    __device__ __forceinline__ void operator()(const f32x4 (&acc)[2][2][4][2], const Unit& u, int wr, int wc, int fr, int fq) const {
        const int row0 = u.pm * BM + wr * 64 + fr; int colt = u.pn * BM; bf16_t* base = O;
        float sc = 1.f; if (split_cols) { const int t = colt / split_cols; base += (size_t)t * split_stride; colt -= t * split_cols; if (t == 0) sc = scale0; }
        const int col0 = colt + wc * 32 + 8 * fq, bcol0 = u.pn * BM + wc * 32 + 8 * fq;
        f32x4 bv[2][2];
#pragma unroll
        for (int bj = 0; bj < 2; ++bj)
#pragma unroll
            for (int n = 0; n < 2; ++n) bv[bj][n] = bias ? *(const f32x4*)(bias + bcol0 + bj * HALF + 4 * n) : (f32x4){0.f, 0.f, 0.f, 0.f};
#pragma unroll
        for (int ai = 0; ai < 2; ++ai)
#pragma unroll
            for (int m = 0; m < 4; ++m) { bf16_t* rowp = base + (size_t)(row0 + ai * HALF + m * 16) * ldc + col0;
#pragma unroll
                for (int bj = 0; bj < 2; ++bj) { f32x4 v0 = acc[ai][bj][m][0] + bv[bj][0], v1 = acc[ai][bj][m][1] + bv[bj][1];
                    if (ACT == 1) { f32x2 a = gelu_pk((f32x2){v0[0], v0[1]}), b = gelu_pk((f32x2){v0[2], v0[3]}), c = gelu_pk((f32x2){v1[0], v1[1]}), d = gelu_pk((f32x2){v1[2], v1[3]});
                        v0 = (f32x4){a.x, a.y, b.x, b.y}; v1 = (f32x4){c.x, c.y, d.x, d.y}; }
                    v0 = v0 * sc; v1 = v1 * sc; u32x4 w; w.x = cvt_pk_bf16(v0[0], v0[1]); w.y = cvt_pk_bf16(v0[2], v0[3]); w.z = cvt_pk_bf16(v1[0], v1[1]); w.w = cvt_pk_bf16(v1[2], v1[3]);
                    *(u32x4*)(rowp + bj * HALF) = w; } }
    }
};
template <class Epi, class Sched, bool ALIGN_EPI = false, bool SP2 = false>
__device__ __forceinline__ void gemm_phase(PG8_LAS unsigned char* lds, const Gemm g, const Sched& S, const Epi& E, const int tid) {
    const int wid = __builtin_amdgcn_readfirstlane(tid >> 6), lane = tid & 63, wr = wid >> 2, wc = wid & 3, fr = lane & 15, fq = lane >> 4;
    const int K = g.K, nt = K / BK;
    unsigned voffA[2], voffB[2];
#pragma unroll
    for (int i = 0; i < 2; ++i) { int R, C; stage_rc(tid * 16 + i * 8192, R, C); const int Rb = Epi::PERM ? ((R & ~31) + perm32(R & 31)) : R;
        voffA[i] = (unsigned)(R * K + C) * 2u; voffB[i] = (unsigned)(Rb * K + C) * 2u; }
    const size_t kstep = (size_t)(BK * 2);
    const size_t hstep = (size_t)HALF * K * 2;
    const size_t tstep = 2 * hstep;
    const unsigned ldsw = (unsigned)wid * 1024u;
    const int aoff = lds_byte(wr * 64 + fr, fq * 8), boff = lds_byte(wc * 32 + fr, fq * 8);
#define PG8_SA(b, h) (((b) * 2 + (h)) * HTB)
#define PG8_SB(b, h) ((4 + (b) * 2 + (h)) * HTB)
#define PG8_STAGE(bufoff, gbase, voff) do { _Pragma("unroll") for (int _i = 0; _i < 2; ++_i) \
        __builtin_amdgcn_global_load_lds((const unsigned*)((const char*)(gbase) + (voff)[_i]), (PG8_LAS unsigned*)(lds + (bufoff) + ldsw + _i * 8192), 16, 0, 0); } while (0)
#define PG8_LDA(dst, b, h) do { _Pragma("unroll") for (int m = 0; m < 4; ++m) _Pragma("unroll") for (int k = 0; k < 2; ++k) dst[m][k] = *(const PG8_LAS bf16x8*)(lds + PG8_SA(b, h) + aoff + m * 2048 + k * 1024); } while (0)
#define PG8_LDB(dst, b, h) do { _Pragma("unroll") for (int n = 0; n < 2; ++n) _Pragma("unroll") for (int k = 0; k < 2; ++k) dst[n][k] = *(const PG8_LAS bf16x8*)(lds + PG8_SB(b, h) + boff + n * 2048 + k * 1024); } while (0)
#define PG8_MMA(ai, bj, At, Bt) do { __builtin_amdgcn_s_setprio(1); _Pragma("unroll") for (int m = 0; m < 4; ++m) _Pragma("unroll") for (int n = 0; n < 2; ++n) _Pragma("unroll") for (int k = 0; k < 2; ++k) \
        acc[ai][bj][m][n] = __builtin_amdgcn_mfma_f32_16x16x32_bf16(Bt[n][k], At[m][k], acc[ai][bj][m][n], 0, 0, 0); __builtin_amdgcn_s_setprio(0); } while (0)
#define PG8_WAIT_V(n) asm volatile("s_waitcnt vmcnt(" #n ")" ::: "memory")
#define PG8_WAIT_L(n) asm volatile("s_waitcnt lgkmcnt(" #n ")" ::: "memory")
#define PG8_BAR __builtin_amdgcn_s_barrier()
#define PG8_SCHED __builtin_amdgcn_sched_barrier(0)
    Unit cur, nxt; int ui = 0;
    if (!S.next(0, cur)) return;
    f32x4 acc[2][2][4][2];
#pragma unroll
    for (int a = 0; a < 2; ++a)
#pragma unroll
        for (int b = 0; b < 2; ++b)
#pragma unroll
            for (int m = 0; m < 4; ++m)
#pragma unroll
                for (int n = 0; n < 2; ++n) acc[a][b][m][n] = (f32x4){0.f, 0.f, 0.f, 0.f};
    bf16x8 At[4][2], B0[2][2], B1[2][2];
    const char* cA = (const char*)g.A + (size_t)cur.pm * tstep; const char* cB = (const char*)g.Bt + (size_t)cur.pn * tstep;
    S.a_ready(cur);
    if constexpr (SP2) {
        PG8_STAGE(PG8_SB(0, 0), cB, voffB); PG8_STAGE(PG8_SB(0, 1), cB + hstep, voffB); PG8_STAGE(PG8_SA(0, 0), cA, voffA); PG8_STAGE(PG8_SA(0, 1), cA + hstep, voffA);
        if (wr == 1) PG8_BAR;
        PG8_WAIT_V(2); PG8_BAR;
        PG8_STAGE(PG8_SB(1, 0), cB + kstep, voffB); PG8_STAGE(PG8_SA(1, 0), cA + kstep, voffA); PG8_STAGE(PG8_SB(1, 1), cB + hstep + kstep, voffB);
        PG8_WAIT_V(6); PG8_BAR;
    } else {
        PG8_STAGE(PG8_SB(0, 0), cB, voffB); PG8_STAGE(PG8_SA(0, 0), cA, voffA); PG8_STAGE(PG8_SB(0, 1), cB + hstep, voffB); PG8_STAGE(PG8_SA(0, 1), cA + hstep, voffA);
        if (wr == 1) PG8_BAR;
        PG8_WAIT_V(4); PG8_BAR;
        PG8_STAGE(PG8_SB(1, 0), cB + kstep, voffB); PG8_STAGE(PG8_SA(1, 0), cA + kstep, voffA); PG8_STAGE(PG8_SB(1, 1), cB + hstep + kstep, voffB);
        PG8_WAIT_V(6); PG8_BAR;
    }
    for (;;) {
        const bool has_next = S.next(ui + 1, nxt);
        const char* nA = has_next ? (const char*)g.A + (size_t)nxt.pm * tstep : cA; const char* nB = has_next ? (const char*)g.Bt + (size_t)nxt.pn * tstep : cB;
        for (int t = 0; t < nt; t += 2) {
            const bool last = (t == nt - 2);
            const char* a1 = cA + (size_t)(t + 1) * kstep;
            const char* a2 = last ? nA : cA + (size_t)(t + 2) * kstep; const char* b2 = last ? nB : cB + (size_t)(t + 2) * kstep;
            const char* a3 = a2 + kstep; const char* b3 = b2 + kstep;
            if (last && has_next) S.a_ready(nxt);
            if constexpr (SP2) {
            PG8_LDB(B0, 0, 0); PG8_LDB(B1, 0, 1); PG8_SCHED; PG8_LDA(At, 0, 0); PG8_STAGE(PG8_SA(1, 1), a1 + hstep, voffA);
            PG8_WAIT_V(8); PG8_WAIT_L(0); PG8_BAR; PG8_MMA(0, 0, At, B0); PG8_MMA(0, 1, At, B1); PG8_BAR; PG8_SCHED;
            PG8_LDA(At, 0, 1); PG8_STAGE(PG8_SB(0, 0), b2, voffB); PG8_STAGE(PG8_SB(0, 1), b2 + hstep, voffB); PG8_STAGE(PG8_SA(0, 0), a2, voffA);
            PG8_WAIT_V(8); PG8_WAIT_L(0); PG8_BAR; PG8_MMA(1, 0, At, B0); PG8_MMA(1, 1, At, B1); PG8_BAR; PG8_SCHED;
            PG8_LDB(B0, 1, 0); PG8_LDB(B1, 1, 1); PG8_SCHED; PG8_LDA(At, 1, 0); PG8_STAGE(PG8_SA(0, 1), a2 + hstep, voffA);
            PG8_WAIT_V(8); PG8_WAIT_L(0); PG8_BAR; PG8_MMA(0, 0, At, B0); PG8_MMA(0, 1, At, B1); PG8_BAR; PG8_SCHED;
            PG8_LDA(At, 1, 1); PG8_STAGE(PG8_SB(1, 0), b3, voffB); PG8_STAGE(PG8_SB(1, 1), b3 + hstep, voffB); PG8_STAGE(PG8_SA(1, 0), a3, voffA);
            PG8_WAIT_V(8); PG8_WAIT_L(0); PG8_BAR; PG8_MMA(1, 0, At, B0); PG8_MMA(1, 1, At, B1); PG8_BAR; PG8_SCHED;
            } else {
            PG8_LDB(B0, 0, 0); PG8_SCHED; PG8_LDA(At, 0, 0); PG8_STAGE(PG8_SA(1, 1), a1 + hstep, voffA);
            PG8_WAIT_L(8); PG8_BAR; PG8_WAIT_L(0); PG8_MMA(0, 0, At, B0); PG8_BAR; PG8_SCHED;
            PG8_LDB(B1, 0, 1); PG8_STAGE(PG8_SB(0, 0), b2, voffB);
            PG8_BAR; PG8_WAIT_L(0); PG8_MMA(0, 1, At, B1); PG8_BAR;
            PG8_LDA(At, 0, 1); PG8_STAGE(PG8_SA(0, 0), a2, voffA);
            PG8_BAR; PG8_WAIT_L(0); PG8_MMA(1, 0, At, B0); PG8_BAR; PG8_SCHED;
            PG8_STAGE(PG8_SB(0, 1), b2 + hstep, voffB);
            PG8_WAIT_V(6); PG8_BAR; PG8_MMA(1, 1, At, B1); PG8_BAR;
            PG8_LDB(B0, 1, 0); PG8_SCHED; PG8_LDA(At, 1, 0); PG8_STAGE(PG8_SA(0, 1), a2 + hstep, voffA);
            PG8_WAIT_L(8); PG8_BAR; PG8_WAIT_L(0); PG8_MMA(0, 0, At, B0); PG8_BAR; PG8_SCHED;
            PG8_LDB(B1, 1, 1); PG8_STAGE(PG8_SB(1, 0), b3, voffB);
            PG8_BAR; PG8_WAIT_L(0); PG8_MMA(0, 1, At, B1); PG8_BAR;
            PG8_LDA(At, 1, 1); PG8_STAGE(PG8_SA(1, 0), a3, voffA);
            PG8_BAR; PG8_WAIT_L(0); PG8_MMA(1, 0, At, B0); PG8_BAR; PG8_SCHED;
            PG8_STAGE(PG8_SB(1, 1), b3 + hstep, voffB);
            PG8_WAIT_V(6); PG8_BAR; PG8_MMA(1, 1, At, B1); PG8_BAR;
            }
        }
        if constexpr (ALIGN_EPI) { if (wr == 0) PG8_BAR; }
        if constexpr (!Epi::AFTER_DRAIN) { E(acc, cur, wr, wc, fr, fq); S.done(cur); }
        if (!has_next) break;
#pragma unroll
        for (int a = 0; a < 2; ++a)
#pragma unroll
            for (int b = 0; b < 2; ++b)
#pragma unroll
                for (int m = 0; m < 4; ++m)
#pragma unroll
                    for (int n = 0; n < 2; ++n) acc[a][b][m][n] = (f32x4){0.f, 0.f, 0.f, 0.f};
        cur = nxt; cA = nA; cB = nB; ++ui;
        if constexpr (ALIGN_EPI) { if (wr == 1) PG8_BAR; }
    }
    PG8_WAIT_V(0);
    if constexpr (!ALIGN_EPI) { if (wr == 0) PG8_BAR; }
    PG8_BAR;
    if constexpr (Epi::AFTER_DRAIN) { E.fused(acc, cur, wr, wc, fr, fq, lds, wid, lane); S.done(cur); }
#undef PG8_SA
#undef PG8_SB
#undef PG8_STAGE
#undef PG8_LDA
#undef PG8_LDB
#undef PG8_MMA
#undef PG8_WAIT_V
#undef PG8_WAIT_L
#undef PG8_BAR
#undef PG8_SCHED
}
}

namespace pg8 {
__device__ __forceinline__ float silu_f(float x) { return x * __builtin_amdgcn_rcpf(1.0f + __expf(-x)); }
struct EpiSwiGLU {
    static constexpr bool PERM = true, AFTER_DRAIN = false;
    bf16_t* U; int ldc;
    __device__ __forceinline__ void operator()(const f32x4 (&acc)[2][2][4][2], const Unit& u, int wr, int wc, int fr, int fq) const {
        const int row0 = u.pm * BM + wr * 64 + fr; const int col0 = u.pn * HALF + wc * 32 + 8 * fq;
#pragma unroll
        for (int ai = 0; ai < 2; ++ai)
#pragma unroll
            for (int m = 0; m < 4; ++m) {
                bf16_t* rowp = U + (size_t)(row0 + ai * HALF + m * 16) * ldc + col0;
                const f32x4 a0 = acc[ai][0][m][0], a1 = acc[ai][0][m][1], g0 = acc[ai][1][m][0], g1 = acc[ai][1][m][1];
                u32x4 w;
                w.x = cvt_pk_bf16(silu_f(a0[0]) * g0[0], silu_f(a0[1]) * g0[1]); w.y = cvt_pk_bf16(silu_f(a0[2]) * g0[2], silu_f(a0[3]) * g0[3]);
                w.z = cvt_pk_bf16(silu_f(a1[0]) * g1[0], silu_f(a1[1]) * g1[1]); w.w = cvt_pk_bf16(silu_f(a1[2]) * g1[2], silu_f(a1[3]) * g1[3]);
                *(u32x4*)rowp = w;
            }
    }
};
struct EpiResid {
    static constexpr bool PERM = true, AFTER_DRAIN = false;
    const float* hin_lat; const float* hin_ctx; float* out_lat; float* out_ctx; const float* gate; float coef; float alpha;
    __device__ __forceinline__ void operator()(const f32x4 (&acc)[2][2][4][2], const Unit& u, int wr, int wc, int fr, int fq) const {
        const bool lat = u.pm < 128;
        const int rbase = (lat ? u.pm : u.pm - 128) * BM + wr * 64 + fr;
        const float* hin = lat ? hin_lat : hin_ctx; float* out = lat ? out_lat : out_ctx;
        const float* gv = gate + (size_t)(lat ? (u.pm >> 3) : 16) * 9216;
        const int col0 = u.pn * BM + wc * 32 + 8 * fq;
        f32x4 g4[2][2];
#pragma unroll
        for (int bj = 0; bj < 2; ++bj)
#pragma unroll
            for (int n = 0; n < 2; ++n) g4[bj][n] = *(const f32x4*)(gv + col0 + bj * HALF + 4 * n) * coef;
#pragma unroll
        for (int ai = 0; ai < 2; ++ai)
#pragma unroll
            for (int m = 0; m < 4; ++m) {
                const size_t off = (size_t)(rbase + ai * HALF + m * 16) * 1024 + col0;
#pragma unroll
                for (int bj = 0; bj < 2; ++bj)
#pragma unroll
                    for (int n = 0; n < 2; ++n) {
                        const f32x4 h4 = *(const f32x4*)(hin + off + bj * HALF + 4 * n);
                        *(f32x4*)(out + off + bj * HALF + 4 * n) = h4 * alpha + g4[bj][n] * acc[ai][bj][m][n];
                    }
            }
    }
};
struct EpiAny {
    static constexpr bool PERM = true, AFTER_DRAIN = false;
    int kind; EpiSwiGLU sw; EpiResid rs;
    __device__ __forceinline__ void operator()(const f32x4 (&acc)[2][2][4][2], const Unit& u, int wr, int wc, int fr, int fq) const {
        if (kind == 0) sw(acc, u, wr, wc, fr, fq);
        else if (kind == 1) rs(acc, u, wr, wc, fr, fq);
        else {
            const int row0 = u.pm * BM + wr * 64 + fr; const int col0 = u.pn * BM + wc * 32 + 8 * fq;
#pragma unroll
            for (int ai = 0; ai < 2; ++ai)
#pragma unroll
                for (int m = 0; m < 4; ++m) {
                    bf16_t* rowp = sw.U + (size_t)(row0 + ai * HALF + m * 16) * sw.ldc + col0;
#pragma unroll
                    for (int bj = 0; bj < 2; ++bj) {
                        const f32x4 v0 = acc[ai][bj][m][0], v1 = acc[ai][bj][m][1];
                        u32x4 w; w.x = cvt_pk_bf16(v0[0], v0[1]); w.y = cvt_pk_bf16(v0[2], v0[3]); w.z = cvt_pk_bf16(v1[0], v1[1]); w.w = cvt_pk_bf16(v1[2], v1[3]);
                        *(u32x4*)(rowp + bj * HALF) = w;
                    }
                }
        }
    }
};
}

#define LAS __attribute__((address_space(3)))
typedef unsigned short bf16;
typedef unsigned v4u __attribute__((ext_vector_type(4)));
typedef unsigned v2u __attribute__((ext_vector_type(2)));
typedef float f32x4 __attribute__((ext_vector_type(4)));
typedef short bf16x8 __attribute__((ext_vector_type(8)));
typedef short s16x4 __attribute__((ext_vector_type(4)));

constexpr int D = 1024, NB = 16, SEQ = 2048, CTXL = 256, DFF = 2816;
constexpr int ML = NB * SEQ, MC = NB * CTXL, MT = ML + MC;
constexpr int MODW = 9 * D;
constexpr int PW0 = 2560, PW1 = 3072;
constexpr float ALPHA = 1.4142135623730951f;
constexpr float LN_EPS = 1e-5f;
constexpr int LDS_BYTES = 147456;
constexpr size_t MiB = 1u << 20;
constexpr size_t WS_MODV = 1 * MiB, WS_HC = 4 * MiB, WS_W13 = 20 * MiB, WS_W2T = 64 * MiB, WS_WIN0 = 86 * MiB, WS_WOUT0 = 91 * MiB, WS_WIN1 = 93 * MiB, WS_WOUT1 = 99 * MiB;
constexpr size_t WS_A = 104 * MiB, WS_U = 176 * MiB, WS_HF = 376 * MiB, WS_END = 440 * MiB;
constexpr size_t W13_BYTES = 11 * MiB, W2T_BYTES = (size_t)1024 * 2816 * 2;

enum { PH_PROLOGUE = 0, PH_LN = 1, PH_UP = 2, PH_RES = 3, PH_BF16 = 4, PH_MIX0 = 5, PH_SCONV = 6 };
struct Phase { int type, M, N, K; const void* a; const void* b; void* o0; void* o1; const void* p0; const void* p1; const void* p2; const void* p3; float f0; int i0; };
struct Args { const float* in[24]; float* out; unsigned char* ws; Phase ph[24]; int nph; int pad; };

__device__ __forceinline__ unsigned f2bf(float f) { unsigned u = __builtin_bit_cast(unsigned, f); return (u + 0x7fffu + ((u >> 16) & 1u)) >> 16; }
__device__ __forceinline__ unsigned pk2(float lo, float hi) { return f2bf(lo) | (f2bf(hi) << 16); }
__device__ __forceinline__ float bf2f(unsigned short b) { return __builtin_bit_cast(float, (unsigned)b << 16); }
__device__ __forceinline__ float bflo(unsigned w) { return __builtin_bit_cast(float, w << 16); }
__device__ __forceinline__ float bfhi(unsigned w) { return __builtin_bit_cast(float, w & 0xffff0000u); }
__device__ __forceinline__ float wave_sum(float v) {
#pragma unroll
    for (int o = 1; o < 64; o <<= 1) v += __shfl_xor(v, o);
    return v;
}
__device__ __forceinline__ float sigmoid_f(float x) { return __builtin_amdgcn_rcpf(1.0f + __expf(-x)); }
__device__ __forceinline__ float gelu_tanh(float x) {
    const float u = 0.7978845608028654f * (x + 0.044715f * x * x * x);
    return x * sigmoid_f(2.0f * u);
}

__device__ __forceinline__ void transpose_item(const float* W, int N, bf16* WT, int K, int k0, int n0, int drow0, LAS float* scr, int lane) {
#pragma unroll 8
    for (int i = 0; i < 32; ++i) { const int kk = 2 * i + (lane >> 5); scr[kk * 33 + (lane & 31)] = W[(size_t)(k0 + kk) * N + n0 + (lane & 31)]; }
    asm volatile("s_waitcnt lgkmcnt(0)" ::: "memory");
    const int c = lane & 7;
#pragma unroll
    for (int j = 0; j < 4; ++j) { const int n = (lane >> 3) + 8 * j; const LAS float* s = scr + (8 * c) * 33 + n;
        v4u o; o.x = pk2(s[0 * 33], s[1 * 33]); o.y = pk2(s[2 * 33], s[3 * 33]); o.z = pk2(s[4 * 33], s[5 * 33]); o.w = pk2(s[6 * 33], s[7 * 33]);
        *(v4u*)(WT + (size_t)(drow0 + n) * K + k0 + 8 * c) = o; }
    asm volatile("s_waitcnt lgkmcnt(0)" ::: "memory");
}

__device__ __forceinline__ void prologue_phase(const Args& args, LAS unsigned char* lds, int bid, int G, int tid, int wave, int lane) {
    const float* c = args.in[1]; const float* c_ctx = args.in[3]; const float* mod_w = args.in[4]; const float* mod_b = args.in[5];
    float* MODV = (float*)(args.ws + WS_MODV);
    LAS float* COND = (LAS float*)lds;
    LAS float* RED = (LAS float*)(lds + 17 * 1024 * 4);
    if (bid < 288) {
        for (int idx = tid; idx < 17 * 1024; idx += 512) { const int b = idx >> 10, k = idx & 1023; const float v = b < 16 ? c[b * 1024 + k] : c_ctx[k]; COND[idx] = v * sigmoid_f(v); }
        __syncthreads();
        for (int it = bid; it < 288; it += G) {
            const int l = it / 144, j0 = (it % 144) * 64;
            float acc[17];
#pragma unroll
            for (int b = 0; b < 17; ++b) acc[b] = 0.f;
            const float* wp = mod_w + (size_t)l * 1024 * MODW + j0 + lane;
            for (int k = 128 * wave; k < 128 * wave + 128; k += 4) {
                const float w0 = wp[(size_t)k * MODW], w1 = wp[(size_t)(k + 1) * MODW], w2 = wp[(size_t)(k + 2) * MODW], w3 = wp[(size_t)(k + 3) * MODW];
#pragma unroll
                for (int b = 0; b < 17; ++b) { const f32x4 c4 = *(const LAS f32x4*)(COND + b * 1024 + k); acc[b] += c4.x * w0 + c4.y * w1 + c4.z * w2 + c4.w * w3; }
            }
#pragma unroll
            for (int b = 0; b < 17; ++b) RED[(wave * 17 + b) * 64 + lane] = acc[b];
            __syncthreads();
            for (int idx = tid; idx < 17 * 64; idx += 512) { const int b = idx >> 6, jj = idx & 63; float s = mod_b[l * MODW + j0 + jj];
#pragma unroll
                for (int w = 0; w < 8; ++w) s += RED[(w * 17 + b) * 64 + jj];
                MODV[(size_t)(l * 17 + b) * MODW + j0 + jj] = s; }
            __syncthreads();
        }
    }
    __syncthreads();
    LAS float* scr = (LAS float*)(lds + wave * 16384);
    const int gw = bid * 8 + wave, NGW = G * 8;
    for (int it = gw; it < 20736; it += NGW) {
        const float* W; bf16* WT; int N, K, r, interleave = 0, ioff = 0;
        if (it < 16896) {
            const int mi = it / 1408; r = it % 1408;
            if (mi < 8) { const int i = mi & 3; W = (mi < 4 ? args.in[8] : args.in[9]) + (size_t)i * 1024 * 2816; WT = (bf16*)(args.ws + WS_W13 + i * W13_BYTES); N = 2816; K = 1024; interleave = 1; ioff = mi < 4 ? 0 : 128; }
            else { const int i = mi - 8; W = args.in[10] + (size_t)i * 2816 * 1024; WT = (bf16*)(args.ws + WS_W2T + i * W2T_BYTES); N = 1024; K = 2816; }
        } else {
            r = it - 16896;
            if (r < 1280) { W = args.in[11]; WT = (bf16*)(args.ws + WS_WIN0); N = 2560; K = 1024; }
            else if (r < 1792) { r -= 1280; W = args.in[20]; WT = (bf16*)(args.ws + WS_WOUT0); N = 1024; K = 1024; }
            else if (r < 3328) { r -= 1792; W = args.in[21]; WT = (bf16*)(args.ws + WS_WIN1); N = 3072; K = 1024; }
            else { r -= 3328; W = args.in[23]; WT = (bf16*)(args.ws + WS_WOUT1); N = 1024; K = 1024; }
        }
        const int nblk = N / 32, kb = r / nblk, nb = r % nblk, n0 = 32 * nb;
        const int drow0 = interleave ? ((n0 >> 7) * 256 + (n0 & 127) + ioff) : n0;
        transpose_item(W, N, WT, K, 64 * kb, n0, drow0, scr, lane);
    }
}

__device__ __forceinline__ void ln_phase(const Phase& p, int bid, int G, int wave, int lane) {
    const float* zl = (const float*)p.a; const float* zc = (const float*)p.b; float* hl = (float*)p.o0; float* hc = (float*)p.o1;
    const float* g = (const float*)p.p0; const float* bb = (const float*)p.p1; const float* modv = (const float*)p.p2; bf16* A = (bf16*)p.p3;
    for (int row = bid * 8 + wave; row < p.M; row += G * 8) {
        const bool lat = row < ML;
        const float* src = lat ? zl + (size_t)row * D : zc + (size_t)(row - ML) * D;
        f32x4 v[4];
#pragma unroll
        for (int j = 0; j < 4; ++j) v[j] = ((const f32x4*)src)[lane + 64 * j];
        if (g) {
            float s = 0.f;
#pragma unroll
            for (int j = 0; j < 4; ++j) s += (v[j].x + v[j].y) + (v[j].z + v[j].w);
            const float mean = wave_sum(s) * (1.f / D); float s2 = 0.f;
#pragma unroll
            for (int j = 0; j < 4; ++j) { v[j] = v[j] - mean; s2 += (v[j].x * v[j].x + v[j].y * v[j].y) + (v[j].z * v[j].z + v[j].w * v[j].w); }
            const float rstd = 1.0f / sqrtf(wave_sum(s2) * (1.f / D) + LN_EPS);
            float* dst = lat ? hl + (size_t)row * D : hc + (size_t)(row - ML) * D;
#pragma unroll
            for (int j = 0; j < 4; ++j) { const f32x4 g4 = ((const f32x4*)g)[lane + 64 * j], b4 = ((const f32x4*)bb)[lane + 64 * j]; v[j] = v[j] * rstd * g4 + b4; ((f32x4*)dst)[lane + 64 * j] = v[j]; }
        }
        if (A) {
            const float* mrow = modv + (size_t)(lat ? (row >> 11) : 16) * MODW;
            v2u* ao = (v2u*)(A + (size_t)row * D);
#pragma unroll
            for (int j = 0; j < 4; ++j) { const f32x4 sh = ((const f32x4*)mrow)[lane + 64 * j], sc = ((const f32x4*)(mrow + D))[lane + 64 * j];
                const f32x4 a = v[j] * (sc + 1.0f) + sh; v2u w; w.x = pk2(a.x, a.y); w.y = pk2(a.z, a.w); ao[lane + 64 * j] = w; }
        }
    }
}

__device__ __forceinline__ void scan_phase(const Args& args, const Phase& p, LAS unsigned char* lds, int bid, int G, int tid, int wave, int lane) {
    const bf16* P = (const bf16*)p.a; bf16* OUT = (bf16*)p.o0; float* HF = (float*)p.o1;
    const float* conv_w = args.in[13]; const float* conv_b = args.in[14]; const float* w_a = args.in[15]; const float* b_a = args.in[16];
    const float* w_x = args.in[17]; const float* b_x = args.in[18]; const float* lam = args.in[19];
    LAS bf16* XB = (LAS bf16*)lds;
    LAS float* XF = (LAS float*)(lds + 18432);
    LAS float* AS = (LAS float*)(lds + 34816);
    LAS float* BS = (LAS float*)(lds + 51200);
    LAS float* AGG = (LAS float*)(lds + 67584);
    LAS float* CARRY = (LAS float*)(lds + 71680);
    const int fr = lane & 15, fq = lane >> 4;
    for (int u = bid; u < 256; u += G) {
        const int b = u >> 4, n = (u >> 1) & 7, half = u & 1;
        const int chb = n * 64 + half * 32;
        for (int dir = 0; dir < 2; ++dir) {
            bf16x8 Wg[2][2][2];
            float bia[2], bix[2], ls8[2];
#pragma unroll
            for (int ct = 0; ct < 2; ++ct) {
                const int chl = half * 32 + 16 * ct + fr;
#pragma unroll
                for (int gt = 0; gt < 2; ++gt) {
                    const float* wsrc = (gt == 0 ? w_a : w_x) + ((size_t)(dir * 8 + n) * 64) * 64 + chl;
#pragma unroll
                    for (int ks = 0; ks < 2; ++ks) {
                        const int k0 = 32 * ks + 8 * fq; v4u w;
                        w.x = pk2(wsrc[(k0 + 0) * 64], wsrc[(k0 + 1) * 64]); w.y = pk2(wsrc[(k0 + 2) * 64], wsrc[(k0 + 3) * 64]);
                        w.z = pk2(wsrc[(k0 + 4) * 64], wsrc[(k0 + 5) * 64]); w.w = pk2(wsrc[(k0 + 6) * 64], wsrc[(k0 + 7) * 64]);
                        Wg[ct][gt][ks] = __builtin_bit_cast(bf16x8, w);
                    }
                }
                bia[ct] = b_a[dir * 512 + n * 64 + chl]; bix[ct] = b_x[dir * 512 + n * 64 + chl];
                const float lm = lam[dir * 512 + n * 64 + chl];
                ls8[ct] = -8.0f * (fmaxf(-lm, 0.f) + log1pf(__expf(-fabsf(lm))));
            }
            __syncthreads();
            if (tid < 32) CARRY[tid] = 0.f;
            for (int step = 0; step < 18; ++step) {
                const int chunk = dir == 0 ? step : (step < 2 ? 1 - step : 19 - step);
                const bool is_ctx = chunk < 2;
                const int s0 = chunk * 128;
                const int seq_lo = is_ctx ? 0 : 256, seq_hi = is_ctx ? 256 : 2304;
                const int row_of_s0 = is_ctx ? (ML + b * CTXL + s0) : (b * SEQ + s0 - 256);
                {
                    const int tt = tid >> 2, cgp = tid & 3, c0 = n * 64 + cgp * 16;
                    float acc[16];
#pragma unroll
                    for (int e = 0; e < 16; ++e) acc[e] = conv_b[c0 + e];
#pragma unroll
                    for (int k = 0; k < 4; ++k) {
                        const int s2 = s0 + tt + k - 2;
                        if (s2 >= seq_lo && s2 < seq_hi) {
                            const bf16* xp = P + (size_t)(row_of_s0 + tt + k - 2) * PW0 + 1536 + c0;
                            const v4u x0 = *(const v4u*)xp, x1 = *(const v4u*)(xp + 8);
                            const float* wk = conv_w + k * 512 + c0;
                            acc[0] += wk[0] * bflo(x0.x); acc[1] += wk[1] * bfhi(x0.x); acc[2] += wk[2] * bflo(x0.y); acc[3] += wk[3] * bfhi(x0.y);
                            acc[4] += wk[4] * bflo(x0.z); acc[5] += wk[5] * bfhi(x0.z); acc[6] += wk[6] * bflo(x0.w); acc[7] += wk[7] * bfhi(x0.w);
                            acc[8] += wk[8] * bflo(x1.x); acc[9] += wk[9] * bfhi(x1.x); acc[10] += wk[10] * bflo(x1.y); acc[11] += wk[11] * bfhi(x1.y);
                            acc[12] += wk[12] * bflo(x1.z); acc[13] += wk[13] * bfhi(x1.z); acc[14] += wk[14] * bflo(x1.w); acc[15] += wk[15] * bfhi(x1.w);
                        }
                    }
                    v4u o0, o1;
                    o0.x = pk2(acc[0], acc[1]); o0.y = pk2(acc[2], acc[3]); o0.z = pk2(acc[4], acc[5]); o0.w = pk2(acc[6], acc[7]);
                    o1.x = pk2(acc[8], acc[9]); o1.y = pk2(acc[10], acc[11]); o1.z = pk2(acc[12], acc[13]); o1.w = pk2(acc[14], acc[15]);
                    *(LAS v4u*)(XB + tt * 72 + cgp * 16) = o0; *(LAS v4u*)(XB + tt * 72 + cgp * 16 + 8) = o1;
                    if ((cgp >> 1) == half) {
                        LAS f32x4* xf = (LAS f32x4*)(XF + tt * 32 + (cgp & 1) * 16);
                        xf[0] = (f32x4){acc[0], acc[1], acc[2], acc[3]}; xf[1] = (f32x4){acc[4], acc[5], acc[6], acc[7]};
                        xf[2] = (f32x4){acc[8], acc[9], acc[10], acc[11]}; xf[3] = (f32x4){acc[12], acc[13], acc[14], acc[15]};
                    }
                }
                __syncthreads();
                {
                    const bf16x8 X0 = *(const LAS bf16x8*)(XB + (16 * wave + fr) * 72 + 8 * fq), X1 = *(const LAS bf16x8*)(XB + (16 * wave + fr) * 72 + 32 + 8 * fq);
#pragma unroll
                    for (int ct = 0; ct < 2; ++ct) {
                        f32x4 da = (f32x4){0.f, 0.f, 0.f, 0.f}, dx = (f32x4){0.f, 0.f, 0.f, 0.f};
                        da = __builtin_amdgcn_mfma_f32_16x16x32_bf16(X0, Wg[ct][0][0], da, 0, 0, 0); da = __builtin_amdgcn_mfma_f32_16x16x32_bf16(X1, Wg[ct][0][1], da, 0, 0, 0);
                        dx = __builtin_amdgcn_mfma_f32_16x16x32_bf16(X0, Wg[ct][1][0], dx, 0, 0, 0); dx = __builtin_amdgcn_mfma_f32_16x16x32_bf16(X1, Wg[ct][1][1], dx, 0, 0, 0);
#pragma unroll
                        for (int v = 0; v < 4; ++v) {
                            const int tt = 16 * wave + 4 * fq + v, chl = 16 * ct + fr;
                            const float xc = XF[tt * 32 + chl];
                            const float gr = sigmoid_f(da[v] + bia[ct]), gi = sigmoid_f(dx[v] + bix[ct]);
                            const float la = ls8[ct] * gr;
                            const float a = __expf(la);
                            const float bbv = sqrtf(fmaxf(-expm1f(2.0f * la), 0.f)) * (gi * xc);
                            const int pp = dir == 0 ? tt : 127 - tt;
                            AS[pp * 32 + chl] = a; BS[pp * 32 + chl] = bbv;
                        }
                    }
                }
                __syncthreads();
                const int ch = tid & 31, sc = tid >> 5;
                {
                    float Aa = 1.f, Bb = 0.f;
#pragma unroll
                    for (int i = 0; i < 8; ++i) { const float a = AS[(8 * sc + i) * 32 + ch], bv = BS[(8 * sc + i) * 32 + ch]; Bb = a * Bb + bv; Aa = a * Aa; }
                    AGG[(sc * 32 + ch) * 2] = Aa; AGG[(sc * 32 + ch) * 2 + 1] = Bb;
                }
                __syncthreads();
                {
                    float h = CARRY[(step & 1) * 32 + ch];
                    for (int i = 0; i < sc; ++i) h = AGG[(i * 32 + ch) * 2] * h + AGG[(i * 32 + ch) * 2 + 1];
#pragma unroll
                    for (int i = 0; i < 8; ++i) {
                        const int pp = 8 * sc + i;
                        h = AS[pp * 32 + ch] * h + BS[pp * 32 + ch];
                        if (!is_ctx) {
                            const int tt = dir == 0 ? pp : 127 - pp;
                            const size_t row = (size_t)(row_of_s0 + tt);
                            if (dir == 0) HF[row * 512 + chb + ch] = h;
                            else {
                                const float y = HF[row * 512 + chb + ch] + h;
                                const float gg = bf2f(P[row * PW0 + 2048 + chb + ch]);
                                OUT[row * D + 512 + chb + ch] = (bf16)f2bf(y * gelu_tanh(gg));
                            }
                        }
                    }
                    if (sc == 15) CARRY[((step + 1) & 1) * 32 + ch] = h;
                }
            }
            __syncthreads();
        }
    }
}

__device__ __forceinline__ void attn_phase(const Args& args, const Phase& p, LAS unsigned char* lds, int bid, int G, int tid, int wave, int lane) {
    const bf16* P = (const bf16*)p.a; bf16* OUT = (bf16*)p.o0; const float* rpb = args.in[12];
    LAS unsigned char* VL = lds;
    LAS unsigned char* VC = lds + 73728;
    LAS float* XCH = (LAS float*)(lds + 110592);
    LAS float* RPB = (LAS float*)(lds + 131072);
    const int fr = lane & 15, fq = lane >> 4, part = wave >> 2, j = wave & 3;
    const int upb = (4096 + G - 1) / G;
    const int u_begin = bid * upb, u_end = (u_begin + upb < 4096) ? u_begin + upb : 4096;
    int prev_bh = -1;
    for (int u = u_begin; u < u_end; ++u) {
        const int bh = u >> 5, r = u & 31, b = bh >> 3, h = bh & 7;
        const int r0 = r < 4 ? 0 : (r > 28 ? 24 : r - 4);
        __syncthreads();
        {
            const bf16* vsrc = P + (size_t)(b * SEQ + r0 * 64) * PW0 + 1024 + h * 64;
            for (int cidx = tid; cidx < 4096; cidx += 512) { const int key = cidx >> 3, chk = cidx & 7; *(LAS v4u*)(VL + key * 144 + chk * 16) = *(const v4u*)(vsrc + (size_t)key * PW0 + chk * 8); }
            if (bh != prev_bh) {
                const bf16* csrc = P + (size_t)(ML + b * CTXL) * PW0 + 1024 + h * 64;
                for (int cidx = tid; cidx < 2048; cidx += 512) { const int key = cidx >> 3, chk = cidx & 7; *(LAS v4u*)(VC + key * 144 + chk * 16) = *(const v4u*)(csrc + (size_t)key * PW0 + chk * 8); }
                for (int i = tid; i < 465; i += 512) RPB[i] = rpb[h * 465 + i];
                prev_bh = bh;
            }
        }
        __syncthreads();
        const int band = j == 0 ? 0 : (j == 3 ? 32 : 16 * j - 8);
        const size_t qtok = (size_t)(b * SEQ + r * 64 + 16 * j + fr);
        const bf16* qp = P + qtok * PW0 + h * 64 + 8 * fq;
        const bf16x8 Q0 = *(const bf16x8*)qp, Q1 = *(const bf16x8*)(qp + 32);
        f32x4 S[16];
#pragma unroll
        for (int kt = 0; kt < 16; ++kt) {
            const size_t krow = part == 0 ? (size_t)(b * SEQ + (r0 + (kt >> 1)) * 64 + band + 16 * (kt & 1) + fr) : (size_t)(ML + b * CTXL + 16 * kt + fr);
            const bf16* kp = P + krow * PW0 + 512 + h * 64 + 8 * fq;
            const bf16x8 K0 = *(const bf16x8*)kp, K1 = *(const bf16x8*)(kp + 32);
            f32x4 s = (f32x4){0.f, 0.f, 0.f, 0.f};
            s = __builtin_amdgcn_mfma_f32_16x16x32_bf16(K0, Q0, s, 0, 0, 0);
            s = __builtin_amdgcn_mfma_f32_16x16x32_bf16(K1, Q1, s, 0, 0, 0);
            S[kt] = s;
        }
        float mx = -1e30f;
        if (part == 0) {
            const int qc = 16 * j + fr; const int start = qc < 8 ? 0 : (qc > 56 ? 48 : qc - 8);
#pragma unroll
            for (int kt = 0; kt < 16; ++kt) {
                const int roff = (r0 + (kt >> 1)) - r + 7;
#pragma unroll
                for (int v = 0; v < 4; ++v) {
                    const int kc = band + 16 * (kt & 1) + 4 * fq + v;
                    const bool valid = (kc >= start) && (kc < start + 16);
                    int ci = kc - qc + 15; ci = ci < 0 ? 0 : (ci > 30 ? 30 : ci);
                    const float bias = RPB[roff * 31 + ci];
                    const float sv = valid ? S[kt][v] * 0.125f + bias : -1e30f;
                    S[kt][v] = sv; mx = fmaxf(mx, sv);
                }
            }
        } else {
#pragma unroll
            for (int kt = 0; kt < 16; ++kt)
#pragma unroll
                for (int v = 0; v < 4; ++v) { const float sv = S[kt][v] * 0.125f; S[kt][v] = sv; mx = fmaxf(mx, sv); }
        }
        mx = fmaxf(mx, __shfl_xor(mx, 16)); mx = fmaxf(mx, __shfl_xor(mx, 32));
        float lsum = 0.f;
#pragma unroll
        for (int kt = 0; kt < 16; ++kt)
#pragma unroll
            for (int v = 0; v < 4; ++v) { const float pv = __expf(S[kt][v] - mx); S[kt][v] = pv; lsum += pv; }
        lsum += __shfl_xor(lsum, 16); lsum += __shfl_xor(lsum, 32);
        f32x4 O[4];
#pragma unroll
        for (int dt = 0; dt < 4; ++dt) O[dt] = (f32x4){0.f, 0.f, 0.f, 0.f};
        const LAS unsigned char* vb = part == 0 ? VL : VC;
#pragma unroll
        for (int i = 0; i < 8; ++i) {
            v4u pw; pw.x = pk2(S[2 * i][0], S[2 * i][1]); pw.y = pk2(S[2 * i][2], S[2 * i][3]); pw.z = pk2(S[2 * i + 1][0], S[2 * i + 1][1]); pw.w = pk2(S[2 * i + 1][2], S[2 * i + 1][3]);
            const bf16x8 Pb = __builtin_bit_cast(bf16x8, pw);
            const int rowb = (part == 0 ? i * 64 + band : 32 * i) + 4 * fq + (fr >> 2);
            const LAS unsigned char* va = vb + rowb * 144 + (fr & 3) * 8;
#pragma unroll
            for (int dt = 0; dt < 4; ++dt) {
                const s16x4 lo = __builtin_amdgcn_ds_read_tr16_b64_v4i16((LAS s16x4*)(va + dt * 32));
                const s16x4 hi = __builtin_amdgcn_ds_read_tr16_b64_v4i16((LAS s16x4*)(va + dt * 32 + 16 * 144));
                const bf16x8 Vop = (bf16x8){lo.x, lo.y, lo.z, lo.w, hi.x, hi.y, hi.z, hi.w};
                O[dt] = __builtin_amdgcn_mfma_f32_16x16x32_bf16(Vop, Pb, O[dt], 0, 0, 0);
            }
        }
        LAS float* xs = XCH + (j * 64 + lane) * 20;
        if (part == 1) {
#pragma unroll
            for (int dt = 0; dt < 4; ++dt) *(LAS f32x4*)(xs + 4 * dt) = O[dt];
            xs[16] = mx; xs[17] = lsum;
        }
        __syncthreads();
        if (part == 0) {
            const float m2 = xs[16], l2 = xs[17];
            const float mm = fmaxf(mx, m2), f1 = __expf(mx - mm), f2 = __expf(m2 - mm);
            const float inv = 1.0f / (lsum * f1 + l2 * f2);
            bf16* op = OUT + qtok * D + h * 64 + 4 * fq;
#pragma unroll
            for (int dt = 0; dt < 4; ++dt) {
                const f32x4 o2 = *(const LAS f32x4*)(xs + 4 * dt);
                const f32x4 o = (O[dt] * f1 + o2 * f2) * inv;
                v2u w; w.x = pk2(o.x, o.y); w.y = pk2(o.z, o.w);
                *(v2u*)(op + 16 * dt) = w;
            }
        }
    }
    __syncthreads();
}

__device__ __forceinline__ void sconv_load_u(const bf16* rp, float (&uu)[8]) {
    const v4u gc = *(const v4u*)(rp + 1024), xv = *(const v4u*)(rp + 2048);
    uu[0] = bflo(gc.x) * bflo(xv.x); uu[1] = bfhi(gc.x) * bfhi(xv.x); uu[2] = bflo(gc.y) * bflo(xv.y); uu[3] = bfhi(gc.y) * bfhi(xv.y);
    uu[4] = bflo(gc.z) * bflo(xv.z); uu[5] = bfhi(gc.z) * bfhi(xv.z); uu[6] = bflo(gc.w) * bflo(xv.w); uu[7] = bfhi(gc.w) * bfhi(xv.w);
}
__device__ __forceinline__ void sconv_phase(const Phase& p, int bid, int G, int tid) {
    const bf16* P = (const bf16*)p.a; const float* cw = (const float*)p.b; bf16* OUT = (bf16*)p.o0;
    for (int it = bid * 512 + tid; it < 2048 * 128; it += G * 512) {
        const int cgi = it & 127, run = it >> 7, c0 = cgi * 8, t0 = run * 16;
        float w0[8], w1[8], w2[8];
#pragma unroll
        for (int e = 0; e < 8; ++e) { w0[e] = cw[c0 + e]; w1[e] = cw[1024 + c0 + e]; w2[e] = cw[2048 + c0 + e]; }
        float up[8], uc[8], un[8];
        if ((t0 & 2047) == 0) {
#pragma unroll
            for (int e = 0; e < 8; ++e) up[e] = 0.f;
        } else sconv_load_u(P + (size_t)(t0 - 1) * PW1 + c0, up);
        sconv_load_u(P + (size_t)t0 * PW1 + c0, uc);
#pragma unroll 4
        for (int i = 0; i < 16; ++i) {
            const int t = t0 + i;
            if (((t + 1) & 2047) == 0) {
#pragma unroll
                for (int e = 0; e < 8; ++e) un[e] = 0.f;
            } else sconv_load_u(P + (size_t)(t + 1) * PW1 + c0, un);
            const v4u gb = *(const v4u*)(P + (size_t)t * PW1 + c0);
            float y[8];
#pragma unroll
            for (int e = 0; e < 8; ++e) y[e] = w0[e] * up[e] + w1[e] * uc[e] + w2[e] * un[e];
            v4u o;
            o.x = pk2(bflo(gb.x) * y[0], bfhi(gb.x) * y[1]); o.y = pk2(bflo(gb.y) * y[2], bfhi(gb.y) * y[3]);
            o.z = pk2(bflo(gb.z) * y[4], bfhi(gb.z) * y[5]); o.w = pk2(bflo(gb.w) * y[6], bfhi(gb.w) * y[7]);
            *(v4u*)(OUT + (size_t)t * D + c0) = o;
#pragma unroll
            for (int e = 0; e < 8; ++e) { up[e] = uc[e]; uc[e] = un[e]; }
        }
    }
}

__global__ void __launch_bounds__(512, 2) fwd_megakernel(Args args) {
    extern __shared__ __attribute__((aligned(16))) unsigned char lds_raw[];
    cg::grid_group grid = cg::this_grid();
    LAS unsigned char* lds = (LAS unsigned char*)lds_raw;
    for (int pi = 0; pi < args.nph; ++pi) {
        const Phase& p = args.ph[pi];
        const int type = p.type;
        int tid = threadIdx.x, bid = blockIdx.x, G = gridDim.x;
        asm volatile("" : "+v"(tid)); asm volatile("" : "+s"(bid)); asm volatile("" : "+s"(G));
        const int lane = tid & 63, wave = __builtin_amdgcn_readfirstlane(tid >> 6);
        if (type == PH_PROLOGUE) {
            prologue_phase(args, lds, bid, G, tid, wave, lane);
        } else if (type == PH_LN) {
            ln_phase(p, bid, G, wave, lane);
        } else if (type == PH_UP || type == PH_RES || type == PH_BF16) {
            pg8::Gemm g{(const pg8::bf16_t*)p.a, (const pg8::bf16_t*)p.b, p.M, p.N, p.K}; pg8::StaticOrder S; S.init(p.M, p.N, G, bid);
            pg8::EpiAny E;
            E.kind = type == PH_UP ? 0 : (type == PH_RES ? 1 : 2);
            E.sw.U = (pg8::bf16_t*)p.o0; E.sw.ldc = type == PH_UP ? DFF : p.N;
            E.rs.hin_lat = (const float*)p.p0; E.rs.hin_ctx = (const float*)p.p1; E.rs.out_lat = (float*)p.o0; E.rs.out_ctx = (float*)p.o1; E.rs.gate = (const float*)p.p2; E.rs.coef = p.f0; E.rs.alpha = ALPHA;
            pg8::gemm_phase<pg8::EpiAny, pg8::StaticOrder, true, true>(lds, g, S, E, tid);
        } else if (type == PH_MIX0) {
            scan_phase(args, p, lds, bid, G, tid, wave, lane);
            attn_phase(args, p, lds, bid, G, tid, wave, lane);
        } else if (type == PH_SCONV) {
            sconv_phase(p, bid, G, tid);
        }
        grid.sync();
    }
}

extern "C" void kernel_launch(void* const* d_in, const int* in_sizes, int n_in, void* d_out, int out_size, void* d_ws, size_t ws_size, hipStream_t stream) {
    static int grid = 0;
    if (grid == 0) {
        if (n_in != 24 || out_size != ML * D || ws_size < WS_END) { fprintf(stderr, "kernel_launch: unexpected shapes (n_in %d out %d ws %zu)\n", n_in, out_size, ws_size); grid = -1; return; }
        int dev = 0, cus = 0, per_cu = 0;
        if (hipGetDevice(&dev) != hipSuccess || hipDeviceGetAttribute(&cus, hipDeviceAttributeMultiprocessorCount, dev) != hipSuccess) { grid = -1; return; }
        if (hipFuncSetAttribute((const void*)fwd_megakernel, hipFuncAttributeMaxDynamicSharedMemorySize, LDS_BYTES) != hipSuccess) { fprintf(stderr, "kernel_launch: hipFuncSetAttribute failed\n"); grid = -1; return; }
        if (hipOccupancyMaxActiveBlocksPerMultiprocessor(&per_cu, (const void*)fwd_megakernel, 512, LDS_BYTES) != hipSuccess || per_cu < 1) { fprintf(stderr, "kernel_launch: occupancy query gave %d\n", per_cu); per_cu = 1; }
        (void)hipGetLastError();
        grid = cus * per_cu;
    }
    if (grid < 0) return;
    Args a{};
    for (int i = 0; i < 24; ++i) a.in[i] = (const float*)d_in[i];
    a.out = (float*)d_out; a.ws = (unsigned char*)d_ws;
    unsigned char* ws = (unsigned char*)d_ws;
    float* MODV = (float*)(ws + WS_MODV); float* HC = (float*)(ws + WS_HC);
    bf16* Abuf = (bf16*)(ws + WS_A); bf16* Ubuf = (bf16*)(ws + WS_U); float* HF = (float*)(ws + WS_HF);
    const float* x = a.in[0]; const float* ctx = a.in[2]; const float* ln_g = a.in[6]; const float* ln_b = a.in[7];
    float* out = (float*)d_out;
    int n = 0;
    auto add = [&](Phase p) { a.ph[n++] = p; };
    auto mk = [&]() { Phase p{}; return p; };
    auto W13 = [&](int i) { return (const void*)(ws + WS_W13 + i * W13_BYTES); };
    auto W2T = [&](int i) { return (const void*)(ws + WS_W2T + i * W2T_BYTES); };
    auto modv = [&](int l, int slot) { return (const void*)(MODV + (size_t)l * 17 * MODW + (size_t)slot * D); };
    auto ph_ln = [&](int M, const float* zl, const float* zc, float* hl, float* hc, const float* g, const float* b, const void* mv, void* A) {
        Phase p = mk(); p.type = PH_LN; p.M = M; p.a = zl; p.b = zc; p.o0 = hl; p.o1 = hc; p.p0 = g; p.p1 = b; p.p2 = mv; p.p3 = A; add(p); };
    auto ph_up = [&](int M, int wi) { Phase p = mk(); p.type = PH_UP; p.M = M; p.N = 2 * DFF; p.K = D; p.a = Abuf; p.b = W13(wi); p.o0 = Ubuf; add(p); };
    auto ph_res = [&](int M, int K, const void* A, const void* Bt, const float* hl, const float* hc, float* ol, float* oc, const void* gate, float coef) {
        Phase p = mk(); p.type = PH_RES; p.M = M; p.N = D; p.K = K; p.a = A; p.b = Bt; p.p0 = hl; p.p1 = hc; p.o0 = ol; p.o1 = oc; p.p2 = gate; p.f0 = coef; add(p); };
    auto ph_bf16 = [&](int M, int N, const void* Bt) { Phase p = mk(); p.type = PH_BF16; p.M = M; p.N = N; p.K = D; p.a = Abuf; p.b = Bt; p.o0 = Ubuf; add(p); };
    { Phase p = mk(); p.type = PH_PROLOGUE; add(p); }
    ph_ln(MT, x, ctx, nullptr, nullptr, nullptr, nullptr, modv(0, 0), Abuf);
    ph_up(MT, 0);
    ph_res(MT, DFF, Ubuf, W2T(0), x, ctx, out, HC, modv(0, 2), 0.5f);
    ph_ln(MT, out, HC, out, HC, ln_g + 0 * D, ln_b + 0 * D, modv(0, 3), Abuf);
    ph_bf16(MT, PW0, ws + WS_WIN0);
    { Phase p = mk(); p.type = PH_MIX0; p.a = Ubuf; p.o0 = Abuf; p.o1 = HF; add(p); }
    ph_res(ML, D, Abuf, ws + WS_WOUT0, out, HC, out, HC, modv(0, 5), 1.0f);
    ph_ln(ML, out, HC, out, HC, ln_g + 1 * D, ln_b + 1 * D, modv(0, 6), Abuf);
    ph_up(ML, 1);
    ph_res(ML, DFF, Ubuf, W2T(1), out, HC, out, HC, modv(0, 8), 0.5f);
    ph_ln(ML, out, HC, out, HC, ln_g + 2 * D, ln_b + 2 * D, modv(1, 0), Abuf);
    ph_up(ML, 2);
    ph_res(ML, DFF, Ubuf, W2T(2), out, HC, out, HC, modv(1, 2), 0.5f);
    ph_ln(ML, out, HC, out, HC, ln_g + 3 * D, ln_b + 3 * D, modv(1, 3), Abuf);
    ph_bf16(ML, PW1, ws + WS_WIN1);
    { Phase p = mk(); p.type = PH_SCONV; p.a = Ubuf; p.b = a.in[22]; p.o0 = Abuf; add(p); }
    ph_res(ML, D, Abuf, ws + WS_WOUT1, out, HC, out, HC, modv(1, 5), 1.0f);
    ph_ln(ML, out, HC, out, HC, ln_g + 4 * D, ln_b + 4 * D, modv(1, 6), Abuf);
    ph_up(ML, 3);
    ph_res(ML, DFF, Ubuf, W2T(3), out, HC, out, HC, modv(1, 8), 0.5f);
    ph_ln(ML, out, HC, out, HC, ln_g + 5 * D, ln_b + 5 * D, nullptr, nullptr);
    a.nph = n;
    void* kargs[] = {&a};
    hipError_t e = hipLaunchCooperativeKernel((const void*)fwd_megakernel, dim3(grid), dim3(512), kargs, LDS_BYTES, stream);
    if (e != hipSuccess) fprintf(stderr, "kernel_launch: cooperative launch failed: %s (grid %d)\n", hipGetErrorString(e), grid);
}
```

```cpp
#include <hip/hip_runtime.h>
#include <hip/hip_cooperative_groups.h>
#include <cstdio>
#include <cstdint>
namespace cg = cooperative_groups;
namespace pg8 {
#define PG8_LAS __attribute__((address_space(3)))
typedef unsigned short bf16_t;
typedef short bf16x8 __attribute__((ext_vector_type(8)));
typedef float f32x4 __attribute__((ext_vector_type(4)));
typedef unsigned u32x4 __attribute__((ext_vector_type(4)));
constexpr int BM = 256, BK = 64, HALF = 128, HTB = HALF * BK * 2  , STAGE_BYTES = 8 * HTB, NXCD = 8, WGM = 8;

__host__ __device__ __forceinline__ int lds_byte(int r, int c) { const int st = (r >> 4) * 2 + (c >> 5), rr = r & 15, cc = c & 31, ob = rr * 64 + cc * 2; return st * 1024 + (ob ^ (((ob >> 9) & 1) << 5)); }
__host__ __device__ __forceinline__ void stage_rc(int b, int& R, int& C) { const int st = b / 1024, sb = b % 1024, swz = sb ^ (((sb >> 9) & 1) << 5); R = (st >> 1) * 16 + swz / 64; C = (st & 1) * 32 + (swz % 64) / 2; }
__host__ __device__ __forceinline__ int perm32(int rho) { const int n = rho >> 4, i = rho & 15; return 8 * (i >> 2) + 4 * n + (i & 3); }

struct Unit { int pm, pn; };
struct Gemm { const bf16_t* A; const bf16_t* Bt; int M, N, K; };

struct StaticOrder {
    int nM, nN, nwg, G, c;
    __host__ __device__ void init(int M, int N, int G_, int c_) { nM = M / BM; nN = N / BM; nwg = nM * nN; G = G_; c = c_; }
    __host__ __device__ bool next(int i, Unit& u) const {
        const long L = (long)i * G + c; if (L >= nwg) return false;
        int wgid = (int)L; { const int q = nwg / NXCD, r = nwg % NXCD, xcd = wgid % NXCD, off = wgid / NXCD; wgid = (xcd < r ? xcd * (q + 1) : r * (q + 1) + (xcd - r) * q) + off; }
        const int nig = WGM * nN, gid = wgid / nig, fm = gid * WGM, gsz = (nM - fm) < WGM ? (nM - fm) : WGM;
        u.pm = fm + ((wgid % nig) % gsz); u.pn = (wgid % nig) / gsz; return true;
    }
    __device__ __forceinline__ void a_ready(const Unit&) const {}
    __device__ __forceinline__ void done(const Unit&) const {}
};

__device__ __forceinline__ unsigned cvt_pk_bf16(float lo, float hi) { unsigned r; asm volatile("v_cvt_pk_bf16_f32 %0, %1, %2" : "=v"(r) : "v"(lo), "v"(hi)); return r; }
typedef float f32x2 __attribute__((ext_vector_type(2)));
__device__ __forceinline__ f32x2 gelu_pk(f32x2 v) {
    const f32x2 av = __builtin_elementwise_abs(v), d = av * 0.2316418882f + 1.0f;
    f32x2 t; t.x = __builtin_amdgcn_rcpf(d.x); t.y = __builtin_amdgcn_rcpf(d.y);
    f32x2 q = t * 0.5307027145f + (-0.7265760135f); q = q * t + 0.7107068705f; q = q * t + (-0.142248368f); q = q * t + 0.127414796f; q = q * t;
    const f32x2 s = (v * v) * (-0.72134752044f);
    f32x2 e; e.x = __builtin_amdgcn_exp2f(s.x); e.y = __builtin_amdgcn_exp2f(s.y);
    const f32x2 m = v * (q * e), r = v - m;
    f32x2 o; o.x = v.x < 0.f ? m.x : r.x; o.y = v.y < 0.f ? m.y : r.y; return o;
}

template <int ACT  > struct EpiBf16 {
    static constexpr bool PERM = true, AFTER_DRAIN = false; static_assert(ACT == 0 || ACT == 1, "EpiBf16: ACT is 0 (none) or 1 (gelu_pk)");
    bf16_t* O; int ldc; const float* bias; int split_cols; size_t split_stride; float scale0;
    __device__ __forceinline__ void operator()(const f32x4 (&acc)[2][2][4][2], const Unit& u, int wr, int wc, int fr, int fq) const {
        const int row0 = u.pm * BM + wr * 64 + fr; int colt = u.pn * BM; bf16_t* base = O;
        float sc = 1.f; if (split_cols) { const int t = colt / split_cols; base += (size_t)t * split_stride; colt -= t * split_cols; if (t == 0) sc = scale0; }
        const int col0 = colt + wc * 32 + 8 * fq, bcol0 = u.pn * BM + wc * 32 + 8 * fq;
        f32x4 bv[2][2];
#pragma unroll
        for (int bj = 0; bj < 2; ++bj)
#pragma unroll
            for (int n = 0; n < 2; ++n) bv[bj][n] = bias ? *(const f32x4*)(bias + bcol0 + bj * HALF + 4 * n) : (f32x4){0.f, 0.f, 0.f, 0.f};
#pragma unroll
        for (int ai = 0; ai < 2; ++ai)
#pragma unroll
            for (int m = 0; m < 4; ++m) { bf16_t* rowp = base + (size_t)(row0 + ai * HALF + m * 16) * ldc + col0;
#pragma unroll
                for (int bj = 0; bj < 2; ++bj) { f32x4 v0 = acc[ai][bj][m][0] + bv[bj][0], v1 = acc[ai][bj][m][1] + bv[bj][1];
                    if (ACT == 1) { f32x2 a = gelu_pk((f32x2){v0[0], v0[1]}), b = gelu_pk((f32x2){v0[2], v0[3]}), c = gelu_pk((f32x2){v1[0], v1[1]}), d = gelu_pk((f32x2){v1[2], v1[3]});
                        v0 = (f32x4){a.x, a.y, b.x, b.y}; v1 = (f32x4){c.x, c.y, d.x, d.y}; }
                    v0 = v0 * sc; v1 = v1 * sc; u32x4 w; w.x = cvt_pk_bf16(v0[0], v0[1]); w.y = cvt_pk_bf16(v0[2], v0[3]); w.z = cvt_pk_bf16(v1[0], v1[1]); w.w = cvt_pk_bf16(v1[2], v1[3]);
                    *(u32x4*)(rowp + bj * HALF) = w; } }
    }
};
template <class Epi, class Sched, bool ALIGN_EPI = false, bool SP2 = false>
__device__ __forceinline__ void gemm_phase(PG8_LAS unsigned char* lds, const Gemm g, const Sched& S, const Epi& E, const int tid) {
    const int wid = __builtin_amdgcn_readfirstlane(tid >> 6), lane = tid & 63, wr = wid >> 2, wc = wid & 3, fr = lane & 15, fq = lane >> 4;
    const int K = g.K, nt = K / BK;
    unsigned voffA[2], voffB[2];
#pragma unroll
    for (int i = 0; i < 2; ++i) { int R, C; stage_rc(tid * 16 + i * 8192, R, C); const int Rb = Epi::PERM ? ((R & ~31) + perm32(R & 31)) : R;
        voffA[i] = (unsigned)(R * K + C) * 2u; voffB[i] = (unsigned)(Rb * K + C) * 2u; }
    const size_t kstep = (size_t)(BK * 2);
    const size_t hstep = (size_t)HALF * K * 2;
    const size_t tstep = 2 * hstep;
    const unsigned ldsw = (unsigned)wid * 1024u;
    const int aoff = lds_byte(wr * 64 + fr, fq * 8), boff = lds_byte(wc * 32 + fr, fq * 8);
#define PG8_SA(b, h) (((b) * 2 + (h)) * HTB)
#define PG8_SB(b, h) ((4 + (b) * 2 + (h)) * HTB)
#define PG8_STAGE(bufoff, gbase, voff) do { _Pragma("unroll") for (int _i = 0; _i < 2; ++_i) \
        __builtin_amdgcn_global_load_lds((const unsigned*)((const char*)(gbase) + (voff)[_i]), (PG8_LAS unsigned*)(lds + (bufoff) + ldsw + _i * 8192), 16, 0, 0); } while (0)
#define PG8_LDA(dst, b, h) do { _Pragma("unroll") for (int m = 0; m < 4; ++m) _Pragma("unroll") for (int k = 0; k < 2; ++k) dst[m][k] = *(const PG8_LAS bf16x8*)(lds + PG8_SA(b, h) + aoff + m * 2048 + k * 1024); } while (0)
#define PG8_LDB(dst, b, h) do { _Pragma("unroll") for (int n = 0; n < 2; ++n) _Pragma("unroll") for (int k = 0; k < 2; ++k) dst[n][k] = *(const PG8_LAS bf16x8*)(lds + PG8_SB(b, h) + boff + n * 2048 + k * 1024); } while (0)
#define PG8_MMA(ai, bj, At, Bt) do { __builtin_amdgcn_s_setprio(1); _Pragma("unroll") for (int m = 0; m < 4; ++m) _Pragma("unroll") for (int n = 0; n < 2; ++n) _Pragma("unroll") for (int k = 0; k < 2; ++k) \
        acc[ai][bj][m][n] = __builtin_amdgcn_mfma_f32_16x16x32_bf16(Bt[n][k], At[m][k], acc[ai][bj][m][n], 0, 0, 0); __builtin_amdgcn_s_setprio(0); } while (0)
#define PG8_WAIT_V(n) asm volatile("s_waitcnt vmcnt(" #n ")" ::: "memory")
#define PG8_WAIT_L(n) asm volatile("s_waitcnt lgkmcnt(" #n ")" ::: "memory")
#define PG8_BAR __builtin_amdgcn_s_barrier()
#define PG8_SCHED __builtin_amdgcn_sched_barrier(0)
    Unit cur, nxt; int ui = 0;
    if (!S.next(0, cur)) return;
    f32x4 acc[2][2][4][2];
#pragma unroll
    for (int a = 0; a < 2; ++a)
#pragma unroll
        for (int b = 0; b < 2; ++b)
#pragma unroll
            for (int m = 0; m < 4; ++m)
#pragma unroll
                for (int n = 0; n < 2; ++n) acc[a][b][m][n] = (f32x4){0.f, 0.f, 0.f, 0.f};
    bf16x8 At[4][2], B0[2][2], B1[2][2];
    const char* cA = (const char*)g.A + (size_t)cur.pm * tstep; const char* cB = (const char*)g.Bt + (size_t)cur.pn * tstep;
    S.a_ready(cur);
    if constexpr (SP2) {
        PG8_STAGE(PG8_SB(0, 0), cB, voffB); PG8_STAGE(PG8_SB(0, 1), cB + hstep, voffB); PG8_STAGE(PG8_SA(0, 0), cA, voffA); PG8_STAGE(PG8_SA(0, 1), cA + hstep, voffA);
        if (wr == 1) PG8_BAR;
        PG8_WAIT_V(2); PG8_BAR;
        PG8_STAGE(PG8_SB(1, 0), cB + kstep, voffB); PG8_STAGE(PG8_SA(1, 0), cA + kstep, voffA); PG8_STAGE(PG8_SB(1, 1), cB + hstep + kstep, voffB);
        PG8_WAIT_V(6); PG8_BAR;
    } else {
        PG8_STAGE(PG8_SB(0, 0), cB, voffB); PG8_STAGE(PG8_SA(0, 0), cA, voffA); PG8_STAGE(PG8_SB(0, 1), cB + hstep, voffB); PG8_STAGE(PG8_SA(0, 1), cA + hstep, voffA);
        if (wr == 1) PG8_BAR;
        PG8_WAIT_V(4); PG8_BAR;
        PG8_STAGE(PG8_SB(1, 0), cB + kstep, voffB); PG8_STAGE(PG8_SA(1, 0), cA + kstep, voffA); PG8_STAGE(PG8_SB(1, 1), cB + hstep + kstep, voffB);
        PG8_WAIT_V(6); PG8_BAR;
    }
    for (;;) {
        const bool has_next = S.next(ui + 1, nxt);
        const char* nA = has_next ? (const char*)g.A + (size_t)nxt.pm * tstep : cA; const char* nB = has_next ? (const char*)g.Bt + (size_t)nxt.pn * tstep : cB;
        for (int t = 0; t < nt; t += 2) {
            const bool last = (t == nt - 2);
            const char* a1 = cA + (size_t)(t + 1) * kstep;
            const char* a2 = last ? nA : cA + (size_t)(t + 2) * kstep; const char* b2 = last ? nB : cB + (size_t)(t + 2) * kstep;
            const char* a3 = a2 + kstep; const char* b3 = b2 + kstep;
            if (last && has_next) S.a_ready(nxt);
            if constexpr (SP2) {
            PG8_LDB(B0, 0, 0); PG8_LDB(B1, 0, 1); PG8_SCHED; PG8_LDA(At, 0, 0); PG8_STAGE(PG8_SA(1, 1), a1 + hstep, voffA);
            PG8_WAIT_V(8); PG8_WAIT_L(0); PG8_BAR; PG8_MMA(0, 0, At, B0); PG8_MMA(0, 1, At, B1); PG8_BAR; PG8_SCHED;
            PG8_LDA(At, 0, 1); PG8_STAGE(PG8_SB(0, 0), b2, voffB); PG8_STAGE(PG8_SB(0, 1), b2 + hstep, voffB); PG8_STAGE(PG8_SA(0, 0), a2, voffA);
            PG8_WAIT_V(8); PG8_WAIT_L(0); PG8_BAR; PG8_MMA(1, 0, At, B0); PG8_MMA(1, 1, At, B1); PG8_BAR; PG8_SCHED;
            PG8_LDB(B0, 1, 0); PG8_LDB(B1, 1, 1); PG8_SCHED; PG8_LDA(At, 1, 0); PG8_STAGE(PG8_SA(0, 1), a2 + hstep, voffA);
            PG8_WAIT_V(8); PG8_WAIT_L(0); PG8_BAR; PG8_MMA(0, 0, At, B0); PG8_MMA(0, 1, At, B1); PG8_BAR; PG8_SCHED;
            PG8_LDA(At, 1, 1); PG8_STAGE(PG8_SB(1, 0), b3, voffB); PG8_STAGE(PG8_SB(1, 1), b3 + hstep, voffB); PG8_STAGE(PG8_SA(1, 0), a3, voffA);
            PG8_WAIT_V(8); PG8_WAIT_L(0); PG8_BAR; PG8_MMA(1, 0, At, B0); PG8_MMA(1, 1, At, B1); PG8_BAR; PG8_SCHED;
            } else {
            PG8_LDB(B0, 0, 0); PG8_SCHED; PG8_LDA(At, 0, 0); PG8_STAGE(PG8_SA(1, 1), a1 + hstep, voffA);
            PG8_WAIT_L(8); PG8_BAR; PG8_WAIT_L(0); PG8_MMA(0, 0, At, B0); PG8_BAR; PG8_SCHED;
            PG8_LDB(B1, 0, 1); PG8_STAGE(PG8_SB(0, 0), b2, voffB);
            PG8_BAR; PG8_WAIT_L(0); PG8_MMA(0, 1, At, B1); PG8_BAR;
            PG8_LDA(At, 0, 1); PG8_STAGE(PG8_SA(0, 0), a2, voffA);
            PG8_BAR; PG8_WAIT_L(0); PG8_MMA(1, 0, At, B0); PG8_BAR; PG8_SCHED;
            PG8_STAGE(PG8_SB(0, 1), b2 + hstep, voffB);
            PG8_WAIT_V(6); PG8_BAR; PG8_MMA(1, 1, At, B1); PG8_BAR;
            PG8_LDB(B0, 1, 0); PG8_SCHED; PG8_LDA(At, 1, 0); PG8_STAGE(PG8_SA(0, 1), a2 + hstep, voffA);
            PG8_WAIT_L(8); PG8_BAR; PG8_WAIT_L(0); PG8_MMA(0, 0, At, B0); PG8_BAR; PG8_SCHED;
            PG8_LDB(B1, 1, 1); PG8_STAGE(PG8_SB(1, 0), b3, voffB);
            PG8_BAR; PG8_WAIT_L(0); PG8_MMA(0, 1, At, B1); PG8_BAR;
            PG8_LDA(At, 1, 1); PG8_STAGE(PG8_SA(1, 0), a3, voffA);
            PG8_BAR; PG8_WAIT_L(0); PG8_MMA(1, 0, At, B0); PG8_BAR; PG8_SCHED;
            PG8_STAGE(PG8_SB(1, 1), b3 + hstep, voffB);
            PG8_WAIT_V(6); PG8_BAR; PG8_MMA(1, 1, At, B1); PG8_BAR;
            }
        }
        if constexpr (ALIGN_EPI) { if (wr == 0) PG8_BAR; }
        if constexpr (!Epi::AFTER_DRAIN) { E(acc, cur, wr, wc, fr, fq); S.done(cur); }
        if (!has_next) break;
#pragma unroll
        for (int a = 0; a < 2; ++a)
#pragma unroll
            for (int b = 0; b < 2; ++b)
#pragma unroll
                for (int m = 0; m < 4; ++m)
#pragma unroll
                    for (int n = 0; n < 2; ++n) acc[a][b][m][n] = (f32x4){0.f, 0.f, 0.f, 0.f};
        cur = nxt; cA = nA; cB = nB; ++ui;
        if constexpr (ALIGN_EPI) { if (wr == 1) PG8_BAR; }
    }
    PG8_WAIT_V(0);
    if constexpr (!ALIGN_EPI) { if (wr == 0) PG8_BAR; }
    PG8_BAR;
    if constexpr (Epi::AFTER_DRAIN) { E.fused(acc, cur, wr, wc, fr, fq, lds, wid, lane); S.done(cur); }
#undef PG8_SA
#undef PG8_SB
#undef PG8_STAGE
#undef PG8_LDA
#undef PG8_LDB
#undef PG8_MMA
#undef PG8_WAIT_V
#undef PG8_WAIT_L
#undef PG8_BAR
#undef PG8_SCHED
}
}

namespace pg8 {
__device__ __forceinline__ float silu_f(float x) { return x * __builtin_amdgcn_rcpf(1.0f + __expf(-x)); }
struct EpiSwiGLU {
    static constexpr bool PERM = true, AFTER_DRAIN = false;
    bf16_t* U; int ldc;
    __device__ __forceinline__ void operator()(const f32x4 (&acc)[2][2][4][2], const Unit& u, int wr, int wc, int fr, int fq) const {
        const int row0 = u.pm * BM + wr * 64 + fr; const int col0 = u.pn * HALF + wc * 32 + 8 * fq;
#pragma unroll
        for (int ai = 0; ai < 2; ++ai)
#pragma unroll
            for (int m = 0; m < 4; ++m) {
                bf16_t* rowp = U + (size_t)(row0 + ai * HALF + m * 16) * ldc + col0;
                const f32x4 a0 = acc[ai][0][m][0], a1 = acc[ai][0][m][1], g0 = acc[ai][1][m][0], g1 = acc[ai][1][m][1];
                u32x4 w;
                w.x = cvt_pk_bf16(silu_f(a0[0]) * g0[0], silu_f(a0[1]) * g0[1]); w.y = cvt_pk_bf16(silu_f(a0[2]) * g0[2], silu_f(a0[3]) * g0[3]);
                w.z = cvt_pk_bf16(silu_f(a1[0]) * g1[0], silu_f(a1[1]) * g1[1]); w.w = cvt_pk_bf16(silu_f(a1[2]) * g1[2], silu_f(a1[3]) * g1[3]);
                *(u32x4*)rowp = w;
            }
    }
};
struct EpiResid {
    static constexpr bool PERM = true, AFTER_DRAIN = false;
    const float* hin_lat; const float* hin_ctx; float* out_lat; float* out_ctx; const float* gate; float coef; float alpha;
    __device__ __forceinline__ void operator()(const f32x4 (&acc)[2][2][4][2], const Unit& u, int wr, int wc, int fr, int fq) const {
        const bool lat = u.pm < 128;
        const int rbase = (lat ? u.pm : u.pm - 128) * BM + wr * 64 + fr;
        const float* hin = lat ? hin_lat : hin_ctx; float* out = lat ? out_lat : out_ctx;
        const float* gv = gate + (size_t)(lat ? (u.pm >> 3) : 16) * 9216;
        const int col0 = u.pn * BM + wc * 32 + 8 * fq;
        f32x4 g4[2][2];
#pragma unroll
        for (int bj = 0; bj < 2; ++bj)
#pragma unroll
            for (int n = 0; n < 2; ++n) g4[bj][n] = *(const f32x4*)(gv + col0 + bj * HALF + 4 * n) * coef;
#pragma unroll
        for (int ai = 0; ai < 2; ++ai)
#pragma unroll
            for (int m = 0; m < 4; ++m) {
                const size_t off = (size_t)(rbase + ai * HALF + m * 16) * 1024 + col0;
#pragma unroll
                for (int bj = 0; bj < 2; ++bj)
#pragma unroll
                    for (int n = 0; n < 2; ++n) {
                        const f32x4 h4 = *(const f32x4*)(hin + off + bj * HALF + 4 * n);
                        *(f32x4*)(out + off + bj * HALF + 4 * n) = h4 * alpha + g4[bj][n] * acc[ai][bj][m][n];
                    }
            }
    }
};
struct EpiAny {
    static constexpr bool PERM = true, AFTER_DRAIN = false;
    int kind; EpiSwiGLU sw; EpiResid rs;
    __device__ __forceinline__ void operator()(const f32x4 (&acc)[2][2][4][2], const Unit& u, int wr, int wc, int fr, int fq) const {
        if (kind == 0) sw(acc, u, wr, wc, fr, fq);
        else if (kind == 1) rs(acc, u, wr, wc, fr, fq);
        else {
            const int row0 = u.pm * BM + wr * 64 + fr; const int col0 = u.pn * BM + wc * 32 + 8 * fq;
#pragma unroll
            for (int ai = 0; ai < 2; ++ai)
#pragma unroll
                for (int m = 0; m < 4; ++m) {
                    bf16_t* rowp = sw.U + (size_t)(row0 + ai * HALF + m * 16) * sw.ldc + col0;
#pragma unroll
                    for (int bj = 0; bj < 2; ++bj) {
                        const f32x4 v0 = acc[ai][bj][m][0], v1 = acc[ai][bj][m][1];
                        u32x4 w; w.x = cvt_pk_bf16(v0[0], v0[1]); w.y = cvt_pk_bf16(v0[2], v0[3]); w.z = cvt_pk_bf16(v1[0], v1[1]); w.w = cvt_pk_bf16(v1[2], v1[3]);
                        *(u32x4*)(rowp + bj * HALF) = w;
                    }
                }
        }
    }
};
}

#define LAS __attribute__((address_space(3)))
typedef unsigned short bf16;
typedef unsigned v4u __attribute__((ext_vector_type(4)));
typedef unsigned v2u __attribute__((ext_vector_type(2)));
typedef float f32x4 __attribute__((ext_vector_type(4)));
typedef short bf16x8 __attribute__((ext_vector_type(8)));
typedef short s16x4 __attribute__((ext_vector_type(4)));

constexpr int D = 1024, NB = 16, SEQ = 2048, CTXL = 256, DFF = 2816;
constexpr int ML = NB * SEQ, MC = NB * CTXL, MT = ML + MC;
constexpr int MODW = 9 * D;
constexpr int PW0 = 2560, PW1 = 3072;
constexpr float ALPHA = 1.4142135623730951f;
constexpr float LN_EPS = 1e-5f;
constexpr int LDS_BYTES = 147456;
constexpr size_t MiB = 1u << 20;
constexpr size_t WS_MODV = 1 * MiB, WS_HC = 4 * MiB, WS_W13 = 20 * MiB, WS_W2T = 64 * MiB, WS_WIN0 = 86 * MiB, WS_WOUT0 = 91 * MiB, WS_WIN1 = 93 * MiB, WS_WOUT1 = 99 * MiB;
constexpr size_t WS_A = 104 * MiB, WS_U = 176 * MiB, WS_HF = 376 * MiB, WS_END = 440 * MiB;
constexpr size_t W13_BYTES = 11 * MiB, W2T_BYTES = (size_t)1024 * 2816 * 2;

enum { PH_PROLOGUE = 0, PH_LN = 1, PH_UP = 2, PH_RES = 3, PH_BF16 = 4, PH_MIX0 = 5, PH_SCONV = 6 };
struct Phase { int type, M, N, K; const void* a; const void* b; void* o0; void* o1; const void* p0; const void* p1; const void* p2; const void* p3; float f0; int i0; };
struct Args { const float* in[24]; float* out; unsigned char* ws; Phase ph[24]; int nph; int pad; };

__device__ __forceinline__ unsigned f2bf(float f) { unsigned u = __builtin_bit_cast(unsigned, f); return (u + 0x7fffu + ((u >> 16) & 1u)) >> 16; }
__device__ __forceinline__ unsigned pk2(float lo, float hi) { return f2bf(lo) | (f2bf(hi) << 16); }
__device__ __forceinline__ float bf2f(unsigned short b) { return __builtin_bit_cast(float, (unsigned)b << 16); }
__device__ __forceinline__ float bflo(unsigned w) { return __builtin_bit_cast(float, w << 16); }
__device__ __forceinline__ float bfhi(unsigned w) { return __builtin_bit_cast(float, w & 0xffff0000u); }
__device__ __forceinline__ float wave_sum(float v) {
#pragma unroll
    for (int o = 1; o < 64; o <<= 1) v += __shfl_xor(v, o);
    return v;
}
__device__ __forceinline__ float sigmoid_f(float x) { return __builtin_amdgcn_rcpf(1.0f + __expf(-x)); }
__device__ __forceinline__ float gelu_tanh(float x) {
    const float u = 0.7978845608028654f * (x + 0.044715f * x * x * x);
    return x * sigmoid_f(2.0f * u);
}

typedef __attribute__((address_space(1))) unsigned gu32;
#define RLX_AGENT __ATOMIC_RELAXED, __HIP_MEMORY_SCOPE_AGENT
#define XB_TMO      128
#define XB_XCNT(j)  (256  + 64 * (j))
#define XB_XSUB(j)  (1280 + 64 * (j))
#define XB_XGEN(j)  (2304 + 64 * (j))
#define XB_TOP      3328
#define XB_TOPGEN   3392
#define XCD_BAR_WORDS 3456
#define XB_SPIN_CAP (1u << 18)

__device__ __forceinline__ unsigned xb_ld(unsigned* p)              { return __hip_atomic_load(p, __ATOMIC_RELAXED, __HIP_MEMORY_SCOPE_AGENT); }
__device__ __forceinline__ unsigned xb_add(unsigned* p, unsigned v) { return __hip_atomic_fetch_add(p, v, __ATOMIC_RELAXED, __HIP_MEMORY_SCOPE_AGENT); }
__device__ __forceinline__ unsigned xb_xcc_id() { return (unsigned)__builtin_amdgcn_s_getreg((3 << 11) | 20) & 0xFu; }
#define XB_SPIN(cond, bar) do { unsigned _sp = 0; while (cond) { __builtin_amdgcn_s_sleep(1); \
    if ((++_sp & 255u) == 0u) { if (xb_ld(&(bar)[XB_TMO])) break; if (_sp > XB_SPIN_CAP) { atomicAdd(&(bar)[XB_TMO], 1u); break; } } } } while (0)

struct XcdBarrier {
    unsigned* bar; unsigned x;
    volatile LAS unsigned* st;
};

__device__ __forceinline__ XcdBarrier xcd_barrier_post(unsigned* bar, volatile LAS unsigned* st) {
    XcdBarrier b; b.bar = bar; b.x = xb_xcc_id(); b.st = st;
    if (threadIdx.x == 0) (void)xb_add(&bar[XB_XCNT(b.x)], 1u);
    return b;
}
__device__ __forceinline__ void xcd_barrier_complete(unsigned* bar, unsigned x, unsigned& nloc, unsigned& nx) {
    const unsigned G = gridDim.x * gridDim.y * gridDim.z;
    unsigned sum, cnt, mine, sp = 0u;
    for (;;) {
        sum = 0u; cnt = 0u; mine = 0u;
#pragma unroll
        for (unsigned j = 0; j < 16; ++j) { const unsigned c = xb_ld(&bar[XB_XCNT(j)]); sum += c; cnt += (c > 0u) ? 1u : 0u; mine = (j == x) ? c : mine; }
        if (sum == G) break;
        __builtin_amdgcn_s_sleep(1);
        if ((++sp & 255u) == 0u) { if (xb_ld(&bar[XB_TMO])) break; if (sp > XB_SPIN_CAP) { atomicAdd(&bar[XB_TMO], 1u); break; } }
    }
    nloc = mine > 0u ? mine : 1u; nx = cnt > 0u ? cnt : 1u;
}

__device__ __forceinline__ void xcd_barrier(const XcdBarrier& b) {
    asm volatile("s_waitcnt vmcnt(0)" ::: "memory");
    __syncthreads();
    if (threadIdx.x == 0) {
        unsigned* bar = b.bar;
        __builtin_amdgcn_s_waitcnt(0);
        unsigned nloc = b.st[0], nx = b.st[1];
        if (nloc == 0u) { xcd_barrier_complete(bar, b.x, nloc, nx); b.st[0] = nloc; b.st[1] = nx; }
        const unsigned old = xb_add(&bar[XB_XSUB(b.x)], 1u);
        const unsigned gen = old / nloc;
        if (old + 1u == (gen + 1u) * nloc) {
            __builtin_amdgcn_fence(__ATOMIC_RELEASE, "agent");
            asm volatile("s_waitcnt vmcnt(0)" ::: "memory");
            const unsigned og = xb_add(&bar[XB_TOP], 1u);
            const unsigned tg = og / nx;
            if (og + 1u == (tg + 1u) * nx) xb_add(&bar[XB_TOPGEN], 1u);
            else XB_SPIN(xb_ld(&bar[XB_TOPGEN]) == tg, bar);
            __builtin_amdgcn_fence(__ATOMIC_ACQUIRE, "agent");
            xb_add(&bar[XB_XGEN(b.x)], 1u);
            asm volatile("s_waitcnt vmcnt(0)" ::: "memory");
        } else {
            XB_SPIN(xb_ld(&bar[XB_XGEN(b.x)]) == gen, bar);
            __builtin_amdgcn_fence(__ATOMIC_ACQUIRE, "agent");
            asm volatile("s_waitcnt vmcnt(0)" ::: "memory");
        }
    }
    __syncthreads();
}

__device__ __forceinline__ void transpose_item(const float* W, int N, bf16* WT, int K, int k0, int n0, int drow0, LAS float* scr, int lane) {
#pragma unroll 8
    for (int i = 0; i < 32; ++i) { const int kk = 2 * i + (lane >> 5); scr[kk * 33 + (lane & 31)] = W[(size_t)(k0 + kk) * N + n0 + (lane & 31)]; }
    asm volatile("s_waitcnt lgkmcnt(0)" ::: "memory");
    const int c = lane & 7;
#pragma unroll
    for (int j = 0; j < 4; ++j) { const int n = (lane >> 3) + 8 * j; const LAS float* s = scr + (8 * c) * 33 + n;
        v4u o; o.x = pk2(s[0 * 33], s[1 * 33]); o.y = pk2(s[2 * 33], s[3 * 33]); o.z = pk2(s[4 * 33], s[5 * 33]); o.w = pk2(s[6 * 33], s[7 * 33]);
        *(v4u*)(WT + (size_t)(drow0 + n) * K + k0 + 8 * c) = o; }
    asm volatile("s_waitcnt lgkmcnt(0)" ::: "memory");
}

__device__ __forceinline__ void prologue_phase(const Args& args, LAS unsigned char* lds, int bid, int G, int tid, int wave, int lane) {
    const float* c = args.in[1]; const float* c_ctx = args.in[3]; const float* mod_w = args.in[4]; const float* mod_b = args.in[5];
    float* MODV = (float*)(args.ws + WS_MODV);
    LAS float* COND = (LAS float*)lds;
    LAS float* RED = (LAS float*)(lds + 17 * 1024 * 4);
    if (bid < 288) {
        for (int idx = tid; idx < 17 * 1024; idx += 512) { const int b = idx >> 10, k = idx & 1023; const float v = b < 16 ? c[b * 1024 + k] : c_ctx[k]; COND[idx] = v * sigmoid_f(v); }
        __syncthreads();
        for (int it = bid; it < 288; it += G) {
            const int l = it / 144, j0 = (it % 144) * 64;
            float acc[17];
#pragma unroll
            for (int b = 0; b < 17; ++b) acc[b] = 0.f;
            const float* wp = mod_w + (size_t)l * 1024 * MODW + j0 + lane;
            for (int k = 128 * wave; k < 128 * wave + 128; k += 4) {
                const float w0 = wp[(size_t)k * MODW], w1 = wp[(size_t)(k + 1) * MODW], w2 = wp[(size_t)(k + 2) * MODW], w3 = wp[(size_t)(k + 3) * MODW];
#pragma unroll
                for (int b = 0; b < 17; ++b) { const f32x4 c4 = *(const LAS f32x4*)(COND + b * 1024 + k); acc[b] += c4.x * w0 + c4.y * w1 + c4.z * w2 + c4.w * w3; }
            }
#pragma unroll
            for (int b = 0; b < 17; ++b) RED[(wave * 17 + b) * 64 + lane] = acc[b];
            __syncthreads();
            for (int idx = tid; idx < 17 * 64; idx += 512) { const int b = idx >> 6, jj = idx & 63; float s = mod_b[l * MODW + j0 + jj];
#pragma unroll
                for (int w = 0; w < 8; ++w) s += RED[(w * 17 + b) * 64 + jj];
                MODV[(size_t)(l * 17 + b) * MODW + j0 + jj] = s; }
            __syncthreads();
        }
    }
    __syncthreads();
    LAS float* scr = (LAS float*)(lds + wave * 16384);
    const int gw = bid * 8 + wave, NGW = G * 8;
    for (int it = gw; it < 20736; it += NGW) {
        const float* W; bf16* WT; int N, K, r, interleave = 0, ioff = 0;
        if (it < 16896) {
            const int mi = it / 1408; r = it % 1408;
            if (mi < 8) { const int i = mi & 3; W = (mi < 4 ? args.in[8] : args.in[9]) + (size_t)i * 1024 * 2816; WT = (bf16*)(args.ws + WS_W13 + i * W13_BYTES); N = 2816; K = 1024; interleave = 1; ioff = mi < 4 ? 0 : 128; }
            else { const int i = mi - 8; W = args.in[10] + (size_t)i * 2816 * 1024; WT = (bf16*)(args.ws + WS_W2T + i * W2T_BYTES); N = 1024; K = 2816; }
        } else {
            r = it - 16896;
            if (r < 1280) { W = args.in[11]; WT = (bf16*)(args.ws + WS_WIN0); N = 2560; K = 1024; }
            else if (r < 1792) { r -= 1280; W = args.in[20]; WT = (bf16*)(args.ws + WS_WOUT0); N = 1024; K = 1024; }
            else if (r < 3328) { r -= 1792; W = args.in[21]; WT = (bf16*)(args.ws + WS_WIN1); N = 3072; K = 1024; }
            else { r -= 3328; W = args.in[23]; WT = (bf16*)(args.ws + WS_WOUT1); N = 1024; K = 1024; }
        }
        const int nblk = N / 32, kb = r / nblk, nb = r % nblk, n0 = 32 * nb;
        const int drow0 = interleave ? ((n0 >> 7) * 256 + (n0 & 127) + ioff) : n0;
        transpose_item(W, N, WT, K, 64 * kb, n0, drow0, scr, lane);
    }
}

__device__ __forceinline__ void ln_phase(const Phase& p, int bid, int G, int wave, int lane) {
    const float* zl = (const float*)p.a; const float* zc = (const float*)p.b; float* hl = (float*)p.o0; float* hc = (float*)p.o1;
    const float* g = (const float*)p.p0; const float* bb = (const float*)p.p1; const float* modv = (const float*)p.p2; bf16* A = (bf16*)p.p3;
    for (int row = bid * 8 + wave; row < p.M; row += G * 8) {
        const bool lat = row < ML;
        const float* src = lat ? zl + (size_t)row * D : zc + (size_t)(row - ML) * D;
        f32x4 v[4];
#pragma unroll
        for (int j = 0; j < 4; ++j) v[j] = ((const f32x4*)src)[lane + 64 * j];
        if (g) {
            float s = 0.f;
#pragma unroll
            for (int j = 0; j < 4; ++j) s += (v[j].x + v[j].y) + (v[j].z + v[j].w);
            const float mean = wave_sum(s) * (1.f / D); float s2 = 0.f;
#pragma unroll
            for (int j = 0; j < 4; ++j) { v[j] = v[j] - mean; s2 += (v[j].x * v[j].x + v[j].y * v[j].y) + (v[j].z * v[j].z + v[j].w * v[j].w); }
            const float rstd = 1.0f / sqrtf(wave_sum(s2) * (1.f / D) + LN_EPS);
            float* dst = lat ? hl + (size_t)row * D : hc + (size_t)(row - ML) * D;
#pragma unroll
            for (int j = 0; j < 4; ++j) { const f32x4 g4 = ((const f32x4*)g)[lane + 64 * j], b4 = ((const f32x4*)bb)[lane + 64 * j]; v[j] = v[j] * rstd * g4 + b4; ((f32x4*)dst)[lane + 64 * j] = v[j]; }
        }
        if (A) {
            const float* mrow = modv + (size_t)(lat ? (row >> 11) : 16) * MODW;
            v2u* ao = (v2u*)(A + (size_t)row * D);
#pragma unroll
            for (int j = 0; j < 4; ++j) { const f32x4 sh = ((const f32x4*)mrow)[lane + 64 * j], sc = ((const f32x4*)(mrow + D))[lane + 64 * j];
                const f32x4 a = v[j] * (sc + 1.0f) + sh; v2u w; w.x = pk2(a.x, a.y); w.y = pk2(a.z, a.w); ao[lane + 64 * j] = w; }
        }
    }
}

__device__ __forceinline__ void scan_phase(const Args& args, const Phase& p, LAS unsigned char* lds, int bid, int G, int tid, int wave, int lane) {
    const bf16* P = (const bf16*)p.a; bf16* OUT = (bf16*)p.o0; float* HF = (float*)p.o1;
    const float* conv_w = args.in[13]; const float* conv_b = args.in[14]; const float* w_a = args.in[15]; const float* b_a = args.in[16];
    const float* w_x = args.in[17]; const float* b_x = args.in[18]; const float* lam = args.in[19];
    LAS bf16* XB = (LAS bf16*)lds;
    LAS float* XF = (LAS float*)(lds + 18432);
    LAS float* AS = (LAS float*)(lds + 34816);
    LAS float* BS = (LAS float*)(lds + 51200);
    LAS float* AGG = (LAS float*)(lds + 67584);
    LAS float* CARRY = (LAS float*)(lds + 71680);
    const int fr = lane & 15, fq = lane >> 4;
    for (int u = bid; u < 256; u += G) {
        const int b = u >> 4, n = (u >> 1) & 7, half = u & 1;
        const int chb = n * 64 + half * 32;
        for (int dir = 0; dir < 2; ++dir) {
            bf16x8 Wg[2][2][2];
            float bia[2], bix[2], ls8[2];
#pragma unroll
            for (int ct = 0; ct < 2; ++ct) {
                const int chl = half * 32 + 16 * ct + fr;
#pragma unroll
                for (int gt = 0; gt < 2; ++gt) {
                    const float* wsrc = (gt == 0 ? w_a : w_x) + ((size_t)(dir * 8 + n) * 64) * 64 + chl;
#pragma unroll
                    for (int ks = 0; ks < 2; ++ks) {
                        const int k0 = 32 * ks + 8 * fq; v4u w;
                        w.x = pk2(wsrc[(k0 + 0) * 64], wsrc[(k0 + 1) * 64]); w.y = pk2(wsrc[(k0 + 2) * 64], wsrc[(k0 + 3) * 64]);
                        w.z = pk2(wsrc[(k0 + 4) * 64], wsrc[(k0 + 5) * 64]); w.w = pk2(wsrc[(k0 + 6) * 64], wsrc[(k0 + 7) * 64]);
                        Wg[ct][gt][ks] = __builtin_bit_cast(bf16x8, w);
                    }
                }
                bia[ct] = b_a[dir * 512 + n * 64 + chl]; bix[ct] = b_x[dir * 512 + n * 64 + chl];
                const float lm = lam[dir * 512 + n * 64 + chl];
                ls8[ct] = -8.0f * (fmaxf(-lm, 0.f) + log1pf(__expf(-fabsf(lm))));
            }
            __syncthreads();
            if (tid < 32) CARRY[tid] = 0.f;
            for (int step = 0; step < 18; ++step) {
                const int chunk = dir == 0 ? step : (step < 2 ? 1 - step : 19 - step);
                const bool is_ctx = chunk < 2;
                const int s0 = chunk * 128;
                const int seq_lo = is_ctx ? 0 : 256, seq_hi = is_ctx ? 256 : 2304;
                const int row_of_s0 = is_ctx ? (ML + b * CTXL + s0) : (b * SEQ + s0 - 256);
                {
                    const int tt = tid >> 2, cgp = tid & 3, c0 = n * 64 + cgp * 16;
                    float acc[16];
#pragma unroll
                    for (int e = 0; e < 16; ++e) acc[e] = conv_b[c0 + e];
#pragma unroll
                    for (int k = 0; k < 4; ++k) {
                        const int s2 = s0 + tt + k - 2;
                        if (s2 >= seq_lo && s2 < seq_hi) {
                            const bf16* xp = P + (size_t)(row_of_s0 + tt + k - 2) * PW0 + 1536 + c0;
                            const v4u x0 = *(const v4u*)xp, x1 = *(const v4u*)(xp + 8);
                            const float* wk = conv_w + k * 512 + c0;
                            acc[0] += wk[0] * bflo(x0.x); acc[1] += wk[1] * bfhi(x0.x); acc[2] += wk[2] * bflo(x0.y); acc[3] += wk[3] * bfhi(x0.y);
                            acc[4] += wk[4] * bflo(x0.z); acc[5] += wk[5] * bfhi(x0.z); acc[6] += wk[6] * bflo(x0.w); acc[7] += wk[7] * bfhi(x0.w);
                            acc[8] += wk[8] * bflo(x1.x); acc[9] += wk[9] * bfhi(x1.x); acc[10] += wk[10] * bflo(x1.y); acc[11] += wk[11] * bfhi(x1.y);
                            acc[12] += wk[12] * bflo(x1.z); acc[13] += wk[13] * bfhi(x1.z); acc[14] += wk[14] * bflo(x1.w); acc[15] += wk[15] * bfhi(x1.w);
                        }
                    }
                    v4u o0, o1;
                    o0.x = pk2(acc[0], acc[1]); o0.y = pk2(acc[2], acc[3]); o0.z = pk2(acc[4], acc[5]); o0.w = pk2(acc[6], acc[7]);
                    o1.x = pk2(acc[8], acc[9]); o1.y = pk2(acc[10], acc[11]); o1.z = pk2(acc[12], acc[13]); o1.w = pk2(acc[14], acc[15]);
                    *(LAS v4u*)(XB + tt * 72 + cgp * 16) = o0; *(LAS v4u*)(XB + tt * 72 + cgp * 16 + 8) = o1;
                    if ((cgp >> 1) == half) {
                        LAS f32x4* xf = (LAS f32x4*)(XF + tt * 32 + (cgp & 1) * 16);
                        xf[0] = (f32x4){acc[0], acc[1], acc[2], acc[3]}; xf[1] = (f32x4){acc[4], acc[5], acc[6], acc[7]};
                        xf[2] = (f32x4){acc[8], acc[9], acc[10], acc[11]}; xf[3] = (f32x4){acc[12], acc[13], acc[14], acc[15]};
                    }
                }
                __syncthreads();
                {
                    const bf16x8 X0 = *(const LAS bf16x8*)(XB + (16 * wave + fr) * 72 + 8 * fq), X1 = *(const LAS bf16x8*)(XB + (16 * wave + fr) * 72 + 32 + 8 * fq);
#pragma unroll
                    for (int ct = 0; ct < 2; ++ct) {
                        f32x4 da = (f32x4){0.f, 0.f, 0.f, 0.f}, dx = (f32x4){0.f, 0.f, 0.f, 0.f};
                        da = __builtin_amdgcn_mfma_f32_16x16x32_bf16(X0, Wg[ct][0][0], da, 0, 0, 0); da = __builtin_amdgcn_mfma_f32_16x16x32_bf16(X1, Wg[ct][0][1], da, 0, 0, 0);
                        dx = __builtin_amdgcn_mfma_f32_16x16x32_bf16(X0, Wg[ct][1][0], dx, 0, 0, 0); dx = __builtin_amdgcn_mfma_f32_16x16x32_bf16(X1, Wg[ct][1][1], dx, 0, 0, 0);
#pragma unroll
                        for (int v = 0; v < 4; ++v) {
                            const int tt = 16 * wave + 4 * fq + v, chl = 16 * ct + fr;
                            const float xc = XF[tt * 32 + chl];
                            const float gr = sigmoid_f(da[v] + bia[ct]), gi = sigmoid_f(dx[v] + bix[ct]);
                            const float la = ls8[ct] * gr;
                            const float a = __expf(la);
                            const float bbv = sqrtf(fmaxf(-expm1f(2.0f * la), 0.f)) * (gi * xc);
                            const int pp = dir == 0 ? tt : 127 - tt;
                            AS[pp * 32 + chl] = a; BS[pp * 32 + chl] = bbv;
                        }
                    }
                }
                __syncthreads();
                const int ch = tid & 31, sc = tid >> 5;
                {
                    float Aa = 1.f, Bb = 0.f;
#pragma unroll
                    for (int i = 0; i < 8; ++i) { const float a = AS[(8 * sc + i) * 32 + ch], bv = BS[(8 * sc + i) * 32 + ch]; Bb = a * Bb + bv; Aa = a * Aa; }
                    AGG[(sc * 32 + ch) * 2] = Aa; AGG[(sc * 32 + ch) * 2 + 1] = Bb;
                }
                __syncthreads();
                {
                    float h = CARRY[(step & 1) * 32 + ch];
                    for (int i = 0; i < sc; ++i) h = AGG[(i * 32 + ch) * 2] * h + AGG[(i * 32 + ch) * 2 + 1];
#pragma unroll
                    for (int i = 0; i < 8; ++i) {
                        const int pp = 8 * sc + i;
                        h = AS[pp * 32 + ch] * h + BS[pp * 32 + ch];
                        if (!is_ctx) {
                            const int tt = dir == 0 ? pp : 127 - pp;
                            const size_t row = (size_t)(row_of_s0 + tt);
                            if (dir == 0) HF[row * 512 + chb + ch] = h;
                            else {
                                const float y = HF[row * 512 + chb + ch] + h;
                                const float gg = bf2f(P[row * PW0 + 2048 + chb + ch]);
                                OUT[row * D + 512 + chb + ch] = (bf16)f2bf(y * gelu_tanh(gg));
                            }
                        }
                    }
                    if (sc == 15) CARRY[((step + 1) & 1) * 32 + ch] = h;
                }
            }
            __syncthreads();
        }
    }
}

__device__ __forceinline__ void attn_phase(const Args& args, const Phase& p, LAS unsigned char* lds, int bid, int G, int tid, int wave, int lane) {
    const bf16* P = (const bf16*)p.a; bf16* OUT = (bf16*)p.o0; const float* rpb = args.in[12];
    LAS unsigned char* VL = lds;
    LAS unsigned char* VC = lds + 73728;
    LAS float* XCH = (LAS float*)(lds + 110592);
    LAS float* RPB = (LAS float*)(lds + 131072);
    const int fr = lane & 15, fq = lane >> 4, part = wave >> 2, j = wave & 3;
    const int upb = (4096 + G - 1) / G;
    const int u_begin = bid * upb, u_end = (u_begin + upb < 4096) ? u_begin + upb : 4096;
    int prev_bh = -1;
    for (int u = u_begin; u < u_end; ++u) {
        const int bh = u >> 5, r = u & 31, b = bh >> 3, h = bh & 7;
        const int r0 = r < 4 ? 0 : (r > 28 ? 24 : r - 4);
        __syncthreads();
        {
            const bf16* vsrc = P + (size_t)(b * SEQ + r0 * 64) * PW0 + 1024 + h * 64;
            for (int cidx = tid; cidx < 4096; cidx += 512) { const int key = cidx >> 3, chk = cidx & 7; *(LAS v4u*)(VL + key * 144 + chk * 16) = *(const v4u*)(vsrc + (size_t)key * PW0 + chk * 8); }
            if (bh != prev_bh) {
                const bf16* csrc = P + (size_t)(ML + b * CTXL) * PW0 + 1024 + h * 64;
                for (int cidx = tid; cidx < 2048; cidx += 512) { const int key = cidx >> 3, chk = cidx & 7; *(LAS v4u*)(VC + key * 144 + chk * 16) = *(const v4u*)(csrc + (size_t)key * PW0 + chk * 8); }
                for (int i = tid; i < 465; i += 512) RPB[i] = rpb[h * 465 + i];
                prev_bh = bh;
            }
        }
        __syncthreads();
        const int band = j == 0 ? 0 : (j == 3 ? 32 : 16 * j - 8);
        const size_t qtok = (size_t)(b * SEQ + r * 64 + 16 * j + fr);
        const bf16* qp = P + qtok * PW0 + h * 64 + 8 * fq;
        const bf16x8 Q0 = *(const bf16x8*)qp, Q1 = *(const bf16x8*)(qp + 32);
        f32x4 S[16];
#pragma unroll
        for (int kt = 0; kt < 16; ++kt) {
            const size_t krow = part == 0 ? (size_t)(b * SEQ + (r0 + (kt >> 1)) * 64 + band + 16 * (kt & 1) + fr) : (size_t)(ML + b * CTXL + 16 * kt + fr);
            const bf16* kp = P + krow * PW0 + 512 + h * 64 + 8 * fq;
            const bf16x8 K0 = *(const bf16x8*)kp, K1 = *(const bf16x8*)(kp + 32);
            f32x4 s = (f32x4){0.f, 0.f, 0.f, 0.f};
            s = __builtin_amdgcn_mfma_f32_16x16x32_bf16(K0, Q0, s, 0, 0, 0);
            s = __builtin_amdgcn_mfma_f32_16x16x32_bf16(K1, Q1, s, 0, 0, 0);
            S[kt] = s;
        }
        float mx = -1e30f;
        if (part == 0) {
            const int qc = 16 * j + fr; const int start = qc < 8 ? 0 : (qc > 56 ? 48 : qc - 8);
#pragma unroll
            for (int kt = 0; kt < 16; ++kt) {
                const int roff = (r0 + (kt >> 1)) - r + 7;
#pragma unroll
                for (int v = 0; v < 4; ++v) {
                    const int kc = band + 16 * (kt & 1) + 4 * fq + v;
                    const bool valid = (kc >= start) && (kc < start + 16);
                    int ci = kc - qc + 15; ci = ci < 0 ? 0 : (ci > 30 ? 30 : ci);
                    const float bias = RPB[roff * 31 + ci];
                    const float sv = valid ? S[kt][v] * 0.125f + bias : -1e30f;
                    S[kt][v] = sv; mx = fmaxf(mx, sv);
                }
            }
        } else {
#pragma unroll
            for (int kt = 0; kt < 16; ++kt)
#pragma unroll
                for (int v = 0; v < 4; ++v) { const float sv = S[kt][v] * 0.125f; S[kt][v] = sv; mx = fmaxf(mx, sv); }
        }
        mx = fmaxf(mx, __shfl_xor(mx, 16)); mx = fmaxf(mx, __shfl_xor(mx, 32));
        float lsum = 0.f;
#pragma unroll
        for (int kt = 0; kt < 16; ++kt)
#pragma unroll
            for (int v = 0; v < 4; ++v) { const float pv = __expf(S[kt][v] - mx); S[kt][v] = pv; lsum += pv; }
        lsum += __shfl_xor(lsum, 16); lsum += __shfl_xor(lsum, 32);
        f32x4 O[4];
#pragma unroll
        for (int dt = 0; dt < 4; ++dt) O[dt] = (f32x4){0.f, 0.f, 0.f, 0.f};
        const LAS unsigned char* vb = part == 0 ? VL : VC;
#pragma unroll
        for (int i = 0; i < 8; ++i) {
            v4u pw; pw.x = pk2(S[2 * i][0], S[2 * i][1]); pw.y = pk2(S[2 * i][2], S[2 * i][3]); pw.z = pk2(S[2 * i + 1][0], S[2 * i + 1][1]); pw.w = pk2(S[2 * i + 1][2], S[2 * i + 1][3]);
            const bf16x8 Pb = __builtin_bit_cast(bf16x8, pw);
            const int rowb = (part == 0 ? i * 64 + band : 32 * i) + 4 * fq + (fr >> 2);
            const LAS unsigned char* va = vb + rowb * 144 + (fr & 3) * 8;
#pragma unroll
            for (int dt = 0; dt < 4; ++dt) {
                const s16x4 lo = __builtin_amdgcn_ds_read_tr16_b64_v4i16((LAS s16x4*)(va + dt * 32));
                const s16x4 hi = __builtin_amdgcn_ds_read_tr16_b64_v4i16((LAS s16x4*)(va + dt * 32 + 16 * 144));
                const bf16x8 Vop = (bf16x8){lo.x, lo.y, lo.z, lo.w, hi.x, hi.y, hi.z, hi.w};
                O[dt] = __builtin_amdgcn_mfma_f32_16x16x32_bf16(Vop, Pb, O[dt], 0, 0, 0);
            }
        }
        LAS float* xs = XCH + (j * 64 + lane) * 20;
        if (part == 1) {
#pragma unroll
            for (int dt = 0; dt < 4; ++dt) *(LAS f32x4*)(xs + 4 * dt) = O[dt];
            xs[16] = mx; xs[17] = lsum;
        }
        __syncthreads();
        if (part == 0) {
            const float m2 = xs[16], l2 = xs[17];
            const float mm = fmaxf(mx, m2), f1 = __expf(mx - mm), f2 = __expf(m2 - mm);
            const float inv = 1.0f / (lsum * f1 + l2 * f2);
            bf16* op = OUT + qtok * D + h * 64 + 4 * fq;
#pragma unroll
            for (int dt = 0; dt < 4; ++dt) {
                const f32x4 o2 = *(const LAS f32x4*)(xs + 4 * dt);
                const f32x4 o = (O[dt] * f1 + o2 * f2) * inv;
                v2u w; w.x = pk2(o.x, o.y); w.y = pk2(o.z, o.w);
                *(v2u*)(op + 16 * dt) = w;
            }
        }
    }
    __syncthreads();
}

__device__ __forceinline__ void sconv_load_u(const bf16* rp, float (&uu)[8]) {
    const v4u gc = *(const v4u*)(rp + 1024), xv = *(const v4u*)(rp + 2048);
    uu[0] = bflo(gc.x) * bflo(xv.x); uu[1] = bfhi(gc.x) * bfhi(xv.x); uu[2] = bflo(gc.y) * bflo(xv.y); uu[3] = bfhi(gc.y) * bfhi(xv.y);
    uu[4] = bflo(gc.z) * bflo(xv.z); uu[5] = bfhi(gc.z) * bfhi(xv.z); uu[6] = bflo(gc.w) * bflo(xv.w); uu[7] = bfhi(gc.w) * bfhi(xv.w);
}
__device__ __forceinline__ void sconv_phase(const Phase& p, int bid, int G, int tid) {
    const bf16* P = (const bf16*)p.a; const float* cw = (const float*)p.b; bf16* OUT = (bf16*)p.o0;
    for (int it = bid * 512 + tid; it < 2048 * 128; it += G * 512) {
        const int cgi = it & 127, run = it >> 7, c0 = cgi * 8, t0 = run * 16;
        float w0[8], w1[8], w2[8];
#pragma unroll
        for (int e = 0; e < 8; ++e) { w0[e] = cw[c0 + e]; w1[e] = cw[1024 + c0 + e]; w2[e] = cw[2048 + c0 + e]; }
        float up[8], uc[8], un[8];
        if ((t0 & 2047) == 0) {
#pragma unroll
            for (int e = 0; e < 8; ++e) up[e] = 0.f;
        } else sconv_load_u(P + (size_t)(t0 - 1) * PW1 + c0, up);
        sconv_load_u(P + (size_t)t0 * PW1 + c0, uc);
#pragma unroll 4
        for (int i = 0; i < 16; ++i) {
            const int t = t0 + i;
            if (((t + 1) & 2047) == 0) {
#pragma unroll
                for (int e = 0; e < 8; ++e) un[e] = 0.f;
            } else sconv_load_u(P + (size_t)(t + 1) * PW1 + c0, un);
            const v4u gb = *(const v4u*)(P + (size_t)t * PW1 + c0);
            float y[8];
#pragma unroll
            for (int e = 0; e < 8; ++e) y[e] = w0[e] * up[e] + w1[e] * uc[e] + w2[e] * un[e];
            v4u o;
            o.x = pk2(bflo(gb.x) * y[0], bfhi(gb.x) * y[1]); o.y = pk2(bflo(gb.y) * y[2], bfhi(gb.y) * y[3]);
            o.z = pk2(bflo(gb.z) * y[4], bfhi(gb.z) * y[5]); o.w = pk2(bflo(gb.w) * y[6], bfhi(gb.w) * y[7]);
            *(v4u*)(OUT + (size_t)t * D + c0) = o;
#pragma unroll
            for (int e = 0; e < 8; ++e) { up[e] = uc[e]; uc[e] = un[e]; }
        }
    }
}

__global__ void __launch_bounds__(512, 2) fwd_megakernel(Args args) {
    extern __shared__ __attribute__((aligned(16))) unsigned char lds_raw[];
    cg::grid_group grid = cg::this_grid();
    LAS unsigned char* lds = (LAS unsigned char*)lds_raw;
    volatile LAS unsigned* bst = (volatile LAS unsigned*)(lds + LDS_BYTES - 64);
    if (threadIdx.x < 16) bst[threadIdx.x] = 0u;
    __syncthreads();
    const XcdBarrier xbar = xcd_barrier_post((unsigned*)args.ws, bst);
    for (int pi = 0; pi < args.nph; ++pi) {
        const Phase& p = args.ph[pi];
        const int type = p.type;
        int tid = threadIdx.x, bid = blockIdx.x, G = gridDim.x;
        asm volatile("" : "+v"(tid)); asm volatile("" : "+s"(bid)); asm volatile("" : "+s"(G));
        const int lane = tid & 63, wave = __builtin_amdgcn_readfirstlane(tid >> 6);
        if (type == PH_PROLOGUE) {
            prologue_phase(args, lds, bid, G, tid, wave, lane);
        } else if (type == PH_LN) {
            ln_phase(p, bid, G, wave, lane);
        } else if (type == PH_UP || type == PH_RES || type == PH_BF16) {
            pg8::Gemm g{(const pg8::bf16_t*)p.a, (const pg8::bf16_t*)p.b, p.M, p.N, p.K}; pg8::StaticOrder S; S.init(p.M, p.N, G, bid);
            pg8::EpiAny E;
            E.kind = type == PH_UP ? 0 : (type == PH_RES ? 1 : 2);
            E.sw.U = (pg8::bf16_t*)p.o0; E.sw.ldc = type == PH_UP ? DFF : p.N;
            E.rs.hin_lat = (const float*)p.p0; E.rs.hin_ctx = (const float*)p.p1; E.rs.out_lat = (float*)p.o0; E.rs.out_ctx = (float*)p.o1; E.rs.gate = (const float*)p.p2; E.rs.coef = p.f0; E.rs.alpha = ALPHA;
            pg8::gemm_phase<pg8::EpiAny, pg8::StaticOrder, true, true>(lds, g, S, E, tid);
        } else if (type == PH_MIX0) {
            scan_phase(args, p, lds, bid, G, tid, wave, lane);
            attn_phase(args, p, lds, bid, G, tid, wave, lane);
        } else if (type == PH_SCONV) {
            sconv_phase(p, bid, G, tid);
        }
        if (pi == 0) grid.sync(); else xcd_barrier(xbar);
    }
}

extern "C" void kernel_launch(void* const* d_in, const int* in_sizes, int n_in, void* d_out, int out_size, void* d_ws, size_t ws_size, hipStream_t stream) {
    static int grid = 0;
    if (grid == 0) {
        if (n_in != 24 || out_size != ML * D || ws_size < WS_END) { fprintf(stderr, "kernel_launch: unexpected shapes (n_in %d out %d ws %zu)\n", n_in, out_size, ws_size); grid = -1; return; }
        int dev = 0, cus = 0, per_cu = 0;
        if (hipGetDevice(&dev) != hipSuccess || hipDeviceGetAttribute(&cus, hipDeviceAttributeMultiprocessorCount, dev) != hipSuccess) { grid = -1; return; }
        if (hipFuncSetAttribute((const void*)fwd_megakernel, hipFuncAttributeMaxDynamicSharedMemorySize, LDS_BYTES) != hipSuccess) { fprintf(stderr, "kernel_launch: hipFuncSetAttribute failed\n"); grid = -1; return; }
        if (hipOccupancyMaxActiveBlocksPerMultiprocessor(&per_cu, (const void*)fwd_megakernel, 512, LDS_BYTES) != hipSuccess || per_cu < 1) { fprintf(stderr, "kernel_launch: occupancy query gave %d\n", per_cu); per_cu = 1; }
        (void)hipGetLastError();
        grid = cus * per_cu;
    }
    if (grid < 0) return;
    if (hipMemsetAsync(d_ws, 0, 65536, stream) != hipSuccess) { fprintf(stderr, "kernel_launch: memset failed\n"); return; }
    Args a{};
    for (int i = 0; i < 24; ++i) a.in[i] = (const float*)d_in[i];
    a.out = (float*)d_out; a.ws = (unsigned char*)d_ws;
    unsigned char* ws = (unsigned char*)d_ws;
    float* MODV = (float*)(ws + WS_MODV); float* HC = (float*)(ws + WS_HC);
    bf16* Abuf = (bf16*)(ws + WS_A); bf16* Ubuf = (bf16*)(ws + WS_U); float* HF = (float*)(ws + WS_HF);
    const float* x = a.in[0]; const float* ctx = a.in[2]; const float* ln_g = a.in[6]; const float* ln_b = a.in[7];
    float* out = (float*)d_out;
    int n = 0;
    auto add = [&](Phase p) { a.ph[n++] = p; };
    auto mk = [&]() { Phase p{}; return p; };
    auto W13 = [&](int i) { return (const void*)(ws + WS_W13 + i * W13_BYTES); };
    auto W2T = [&](int i) { return (const void*)(ws + WS_W2T + i * W2T_BYTES); };
    auto modv = [&](int l, int slot) { return (const void*)(MODV + (size_t)l * 17 * MODW + (size_t)slot * D); };
    auto ph_ln = [&](int M, const float* zl, const float* zc, float* hl, float* hc, const float* g, const float* b, const void* mv, void* A) {
        Phase p = mk(); p.type = PH_LN; p.M = M; p.a = zl; p.b = zc; p.o0 = hl; p.o1 = hc; p.p0 = g; p.p1 = b; p.p2 = mv; p.p3 = A; add(p); };
    auto ph_up = [&](int M, int wi) { Phase p = mk(); p.type = PH_UP; p.M = M; p.N = 2 * DFF; p.K = D; p.a = Abuf; p.b = W13(wi); p.o0 = Ubuf; add(p); };
    auto ph_res = [&](int M, int K, const void* A, const void* Bt, const float* hl, const float* hc, float* ol, float* oc, const void* gate, float coef) {
        Phase p = mk(); p.type = PH_RES; p.M = M; p.N = D; p.K = K; p.a = A; p.b = Bt; p.p0 = hl; p.p1 = hc; p.o0 = ol; p.o1 = oc; p.p2 = gate; p.f0 = coef; add(p); };
    auto ph_bf16 = [&](int M, int N, const void* Bt) { Phase p = mk(); p.type = PH_BF16; p.M = M; p.N = N; p.K = D; p.a = Abuf; p.b = Bt; p.o0 = Ubuf; add(p); };
    { Phase p = mk(); p.type = PH_PROLOGUE; add(p); }
    ph_ln(MT, x, ctx, nullptr, nullptr, nullptr, nullptr, modv(0, 0), Abuf);
    ph_up(MT, 0);
    ph_res(MT, DFF, Ubuf, W2T(0), x, ctx, out, HC, modv(0, 2), 0.5f);
    ph_ln(MT, out, HC, out, HC, ln_g + 0 * D, ln_b + 0 * D, modv(0, 3), Abuf);
    ph_bf16(MT, PW0, ws + WS_WIN0);
    { Phase p = mk(); p.type = PH_MIX0; p.a = Ubuf; p.o0 = Abuf; p.o1 = HF; add(p); }
    ph_res(ML, D, Abuf, ws + WS_WOUT0, out, HC, out, HC, modv(0, 5), 1.0f);
    ph_ln(ML, out, HC, out, HC, ln_g + 1 * D, ln_b + 1 * D, modv(0, 6), Abuf);
    ph_up(ML, 1);
    ph_res(ML, DFF, Ubuf, W2T(1), out, HC, out, HC, modv(0, 8), 0.5f);
    ph_ln(ML, out, HC, out, HC, ln_g + 2 * D, ln_b + 2 * D, modv(1, 0), Abuf);
    ph_up(ML, 2);
    ph_res(ML, DFF, Ubuf, W2T(2), out, HC, out, HC, modv(1, 2), 0.5f);
    ph_ln(ML, out, HC, out, HC, ln_g + 3 * D, ln_b + 3 * D, modv(1, 3), Abuf);
    ph_bf16(ML, PW1, ws + WS_WIN1);
    { Phase p = mk(); p.type = PH_SCONV; p.a = Ubuf; p.b = a.in[22]; p.o0 = Abuf; add(p); }
    ph_res(ML, D, Abuf, ws + WS_WOUT1, out, HC, out, HC, modv(1, 5), 1.0f);
    ph_ln(ML, out, HC, out, HC, ln_g + 4 * D, ln_b + 4 * D, modv(1, 6), Abuf);
    ph_up(ML, 3);
    ph_res(ML, DFF, Ubuf, W2T(3), out, HC, out, HC, modv(1, 8), 0.5f);
    ph_ln(ML, out, HC, out, HC, ln_g + 5 * D, ln_b + 5 * D, nullptr, nullptr);
    a.nph = n;
    void* kargs[] = {&a};
    hipError_t e = hipLaunchCooperativeKernel((const void*)fwd_megakernel, dim3(grid), dim3(512), kargs, LDS_BYTES, stream);
    if (e != hipSuccess) fprintf(stderr, "kernel_launch: cooperative launch failed: %s (grid %d)\n", hipGetErrorString(e), grid);
}
```
